# Optimizing an MI355X kernel written in HIP

```python
import math
import jax
import jax.numpy as jnp
from jax import lax
import numpy as np

D_MODEL = 4096
BATCH = 2
SEQ = 8192
DEPTH = 1
DEC_BATCH = 16
DEC_SEQ = 16
PAST_LEN = 1024

CHUNK = 64
MIX_WIDTH = D_MODEL
HD_DIFF = 128
H_DIFF = (MIX_WIDTH // 2) // (2 * HD_DIFF)
H_GLA = 4
GLA_DK = (MIX_WIDTH // 4) // H_GLA
GLA_DV = (MIX_WIDTH // 2) // H_GLA
GATE_RANK = 16
GLA_TAU = 16.0
ROPE_THETA = 10000.0
Q_BLOCK = 128
N_KEYS = 128
N_EXPERTS = N_KEYS * N_KEYS
PEER_HEADS = 8
PEER_DKEY = 256
PEER_HALF = PEER_DKEY // 2
PEER_TOPK = 16
PEER_BLOCK = 128
ALPHA = (2 * DEPTH) ** 0.25
BETA = (8 * DEPTH) ** -0.25
EPS = 1e-5
NEG_INF = -1e30

DIFF_QK = H_DIFF * 2 * HD_DIFF
DIFF_V = H_DIFF * 2 * HD_DIFF
GLA_QK = H_GLA * GLA_DK
GLA_V = H_GLA * GLA_DV
SPLIT_SIZES = (DIFF_QK, DIFF_QK, DIFF_V, GLA_QK, GLA_QK, GLA_V, GLA_V, GATE_RANK)
IN_COLS = sum(SPLIT_SIZES)

kernel_name = "hybrid_diffattn_gla_peer_stream_step"


def layernorm(x, g, b):
    xf = x.astype(jnp.float32)
    mu = jnp.mean(xf, axis=-1, keepdims=True)
    var = jnp.mean(jnp.square(xf - mu), axis=-1, keepdims=True)
    return ((xf - mu) * lax.rsqrt(var + EPS)).astype(x.dtype) * g + b


def rmsnorm(x, g):
    xf = x.astype(jnp.float32)
    return (xf * lax.rsqrt(jnp.mean(jnp.square(xf), axis=-1, keepdims=True) + EPS)).astype(x.dtype) * g


def rope(x, pos):
    d = x.shape[-1]
    inv = ROPE_THETA ** (-jnp.arange(0, d, 2, dtype=jnp.float32) / d)
    ang = pos.astype(jnp.float32)[:, None] * inv[None, :]
    ang = jnp.concatenate([ang, ang], axis=-1)
    cos = jnp.cos(ang)[:, None, None, :].astype(x.dtype)
    sin = jnp.sin(ang)[:, None, None, :].astype(x.dtype)
    x1, x2 = jnp.split(x, 2, axis=-1)
    return x * cos + jnp.concatenate([-x2, x1], axis=-1) * sin


def diff_attention(q, qpos, k, v, kpos, lam):
    B, T = q.shape[:2]
    qblk = Q_BLOCK if T % Q_BLOCK == 0 else T
    nblk = T // qblk
    qs = q.reshape(B, nblk, qblk, H_DIFF, 2, HD_DIFF).swapaxes(0, 1)
    qp = qpos.reshape(nblk, qblk)
    kchunk = kpos // CHUNK
    scale = HD_DIFF ** -0.5

    def block(args):
        qb, pb = args
        s = jnp.einsum('bqhid,bkhid->bihqk', qb, k).astype(jnp.float32) * scale
        mask = (pb // CHUNK)[:, None] >= kchunk[None, :]
        p = jax.nn.softmax(jnp.where(mask, s, NEG_INF), axis=-1)
        w = p[:, 0] - lam * p[:, 1]
        return jnp.einsum('bhqk,bkhe->bqhe', w.astype(v.dtype), v)

    o = lax.map(block, (qs, qp))
    return o.swapaxes(0, 1).reshape(B, T, H_DIFF, 2 * HD_DIFF)


def gla_chunked(q, k, v, logf, s0, L):
    B, T, H, dk = q.shape
    dv = v.shape[-1]
    n = T // L
    scale = dk ** -0.5
    causal = jnp.tril(jnp.ones((L, L), dtype=bool))

    def to_chunks(a):
        return a.astype(jnp.float32).reshape(B, n, L, H, a.shape[-1]).transpose(1, 0, 3, 2, 4)

    def step(S, inp):
        qc, kc, vc, gc = inp
        b = jnp.cumsum(gc, axis=-2)
        b_last = b[..., -1:, :]
        q_in = qc * jnp.exp(b) * scale
        k_in = kc * jnp.exp(-b)
        k_end = kc * jnp.exp(b_last - b)
        a = jnp.where(causal, jnp.einsum('bhtk,bhsk->bhts', q_in, k_in), 0.0)
        o = jnp.einsum('bhts,bhsv->bhtv', a, vc) + jnp.einsum('bhtk,bhkv->bhtv', q_in, S)
        S = jnp.exp(b_last).swapaxes(-1, -2) * S + jnp.einsum('bhsk,bhsv->bhkv', k_end, vc)
        return S, o

    S, o = lax.scan(step, s0.astype(jnp.float32), (to_chunks(q), to_chunks(k), to_chunks(v), to_chunks(logf)))
    o = o.transpose(1, 0, 3, 2, 4).reshape(B, T, H, dv)
    return o, S


def peer(x, w_q, keys1, keys2, u_tab, v_tab):
    B, T, D = x.shape
    n = B * T
    blk = min(PEER_BLOCK, n)
    nb = -(-n // blk)
    xt = jnp.pad(x.reshape(n, D), ((0, nb * blk - n), (0, 0))).reshape(nb, blk, D)

    def one(xb):
        q = (xb @ w_q).reshape(blk, PEER_HEADS, 2, PEER_HALF)
        s1 = jnp.einsum('nhd,hkd->nhk', q[:, :, 0], keys1).astype(jnp.float32)
        s2 = jnp.einsum('nhd,hkd->nhk', q[:, :, 1], keys2).astype(jnp.float32)
        t1, i1 = lax.top_k(s1, PEER_TOPK)
        t2, i2 = lax.top_k(s2, PEER_TOPK)
        cand = (t1[..., :, None] + t2[..., None, :]).reshape(blk, PEER_HEADS, PEER_TOPK * PEER_TOPK)
        cidx = (i1[..., :, None] * N_KEYS + i2[..., None, :]).reshape(blk, PEER_HEADS, PEER_TOPK * PEER_TOPK)
        best, sel = lax.top_k(cand, PEER_TOPK)
        idx = jnp.take_along_axis(cidx, sel, axis=-1)
        g = jax.nn.softmax(best, axis=-1)
        u = jnp.take(u_tab, idx, axis=0)
        act = jax.nn.gelu(jnp.einsum('nd,nhkd->nhk', xb, u), approximate=False)
        coeff = (g * act.astype(jnp.float32)).astype(xb.dtype)
        return jnp.einsum('nhk,nhkd->nd', coeff, jnp.take(v_tab, idx, axis=0))

    y = lax.map(one, xt).reshape(nb * blk, D)[:n]
    return y.reshape(B, T, D)


def encoder_layer(x, pos, past_k, past_v, gla_s0, gla_chunk, lam_init,
                  w_in, w_gate2, b_gate, lam_q1, lam_k1, lam_q2, lam_k2,
                  diff_norm_g, gla_norm_g, w_out, ln1_g, ln1_b, ln2_g, ln2_b,
                  peer_wq, peer_keys1, peer_keys2, peer_u, peer_v):
    B, T, _ = x.shape
    proj = x @ w_in
    points = np.cumsum(SPLIT_SIZES)[:-1].tolist()
    dq, dk, dv, gq, gk, gv, gr, gz = jnp.split(proj, points, axis=-1)

    dq = rope(dq.reshape(B, T, H_DIFF, 2, HD_DIFF), pos)
    dk = rope(dk.reshape(B, T, H_DIFF, 2, HD_DIFF), pos)
    dv = dv.reshape(B, T, H_DIFF, 2 * HD_DIFF)
    new_k = dk.reshape(B, T, H_DIFF, 2 * HD_DIFF)
    new_v = dv
    if past_k is None:
        keys, vals, kpos = dk, dv, pos
    else:
        P = past_k.shape[1]
        keys = jnp.concatenate([past_k.reshape(B, P, H_DIFF, 2, HD_DIFF).astype(dk.dtype), dk], axis=1)
        vals = jnp.concatenate([past_v.astype(dv.dtype), dv], axis=1)
        kpos = jnp.arange(P + T, dtype=jnp.int32)
    lam = (jnp.exp(jnp.sum(lam_q1.astype(jnp.float32) * lam_k1.astype(jnp.float32)))
           - jnp.exp(jnp.sum(lam_q2.astype(jnp.float32) * lam_k2.astype(jnp.float32))) + lam_init)
    o_diff = diff_attention(dq, pos, keys, vals, kpos, lam)
    o_diff = rmsnorm(o_diff, diff_norm_g) * (1.0 - lam_init)

    logf = jax.nn.log_sigmoid((gz @ w_gate2 + b_gate).astype(jnp.float32)) / GLA_TAU
    o_gla, s_new = gla_chunked(gq.reshape(B, T, H_GLA, GLA_DK), gk.reshape(B, T, H_GLA, GLA_DK),
                               gv.reshape(B, T, H_GLA, GLA_DV), logf.reshape(B, T, H_GLA, GLA_DK),
                               gla_s0, gla_chunk)
    o_gla = rmsnorm(o_gla.astype(x.dtype), gla_norm_g) * jax.nn.silu(gr.reshape(B, T, H_GLA, GLA_DV))

    mix = jnp.concatenate([o_diff.reshape(B, T, DIFF_V), o_gla.reshape(B, T, GLA_V)], axis=-1) @ w_out
    x1 = layernorm(ALPHA * x + mix, ln1_g, ln1_b)
    x2 = layernorm(ALPHA * x1 + peer(x1, peer_wq, peer_keys1, peer_keys2, peer_u, peer_v), ln2_g, ln2_b)
    return x2, new_k, new_v, s_new.astype(x.dtype)


def setup_inputs(seed: int = 0) -> dict:
    key = jax.random.key(seed)
    ks = jax.random.split(key, 26)
    nrm = jax.random.normal
    f32 = jnp.float32
    return {
        "x_prompt": nrm(ks[0], (BATCH, SEQ, D_MODEL), f32),
        "x_sample": nrm(ks[1], (DEC_BATCH, DEC_SEQ, D_MODEL), f32),
        "cache_diff_k": nrm(ks[2], (DEPTH, DEC_BATCH, PAST_LEN, H_DIFF, 2 * HD_DIFF), f32),
        "cache_diff_v": nrm(ks[3], (DEPTH, DEC_BATCH, PAST_LEN, H_DIFF, 2 * HD_DIFF), f32),
        "state_gla": nrm(ks[4], (DEPTH, DEC_BATCH, H_GLA, GLA_DK, GLA_DV), f32),
        "w_in": nrm(ks[5], (DEPTH, D_MODEL, IN_COLS), f32) * D_MODEL ** -0.5,
        "w_gate2": nrm(ks[6], (DEPTH, GATE_RANK, GLA_QK), f32) * GATE_RANK ** -0.5,
        "b_gate": nrm(ks[7], (DEPTH, GLA_QK), f32) * 0.1,
        "lam_q1": nrm(ks[8], (DEPTH, HD_DIFF), f32) * 0.1,
        "lam_k1": nrm(ks[9], (DEPTH, HD_DIFF), f32) * 0.1,
        "lam_q2": nrm(ks[10], (DEPTH, HD_DIFF), f32) * 0.1,
        "lam_k2": nrm(ks[11], (DEPTH, HD_DIFF), f32) * 0.1,
        "diff_norm_g": 1.0 + 0.01 * nrm(ks[12], (DEPTH, 2 * HD_DIFF), f32),
        "gla_norm_g": 1.0 + 0.01 * nrm(ks[13], (DEPTH, GLA_DV), f32),
        "w_out": nrm(ks[14], (DEPTH, MIX_WIDTH, D_MODEL), f32) * (MIX_WIDTH ** -0.5 * BETA),
        "ln1_g": 1.0 + 0.01 * nrm(ks[15], (DEPTH, D_MODEL), f32),
        "ln1_b": 0.01 * nrm(ks[16], (DEPTH, D_MODEL), f32),
        "ln2_g": 1.0 + 0.01 * nrm(ks[17], (DEPTH, D_MODEL), f32),
        "ln2_b": 0.01 * nrm(ks[18], (DEPTH, D_MODEL), f32),
        "peer_wq": nrm(ks[19], (DEPTH, D_MODEL, PEER_HEADS * PEER_DKEY), f32) * D_MODEL ** -0.5,
        "peer_keys1": nrm(ks[20], (DEPTH, PEER_HEADS, N_KEYS, PEER_HALF), f32) * PEER_HALF ** -0.5,
        "peer_keys2": nrm(ks[21], (DEPTH, PEER_HEADS, N_KEYS, PEER_HALF), f32) * PEER_HALF ** -0.5,
        "peer_u": nrm(ks[22], (DEPTH, N_EXPERTS, D_MODEL), f32) * D_MODEL ** -0.5,
        "peer_v": nrm(ks[23], (DEPTH, N_EXPERTS, D_MODEL), f32) * (BETA * PEER_HEADS ** -0.5),
    }


def reference(x_prompt, x_sample, cache_diff_k, cache_diff_v, state_gla,
              w_in, w_gate2, b_gate, lam_q1, lam_k1, lam_q2, lam_k2,
              diff_norm_g, gla_norm_g, w_out, ln1_g, ln1_b, ln2_g, ln2_b,
              peer_wq, peer_keys1, peer_keys2, peer_u, peer_v):
    Bp, Tp = x_prompt.shape[:2]
    Ts = x_sample.shape[1]
    P = cache_diff_k.shape[2]
    pos_p = jnp.arange(Tp, dtype=jnp.int32)
    pos_s = P + jnp.arange(Ts, dtype=jnp.int32)
    y_p, y_s = x_prompt, x_sample
    kp_list, vp_list, sp_list, ks_list, vs_list, ss_list = [], [], [], [], [], []
    for l in range(DEPTH):
        lam_init = 0.8 - 0.6 * math.exp(-0.3 * l)
        params = (w_in[l], w_gate2[l], b_gate[l], lam_q1[l], lam_k1[l], lam_q2[l], lam_k2[l],
                  diff_norm_g[l], gla_norm_g[l], w_out[l], ln1_g[l], ln1_b[l], ln2_g[l], ln2_b[l],
                  peer_wq[l], peer_keys1[l], peer_keys2[l], peer_u[l], peer_v[l])
        s0 = jnp.zeros((Bp, H_GLA, GLA_DK, GLA_DV), jnp.float32)
        y_p, kp, vp, sp = encoder_layer(y_p, pos_p, None, None, s0, CHUNK, lam_init, *params)
        y_s, k_s, v_s, s_s = encoder_layer(y_s, pos_s, cache_diff_k[l], cache_diff_v[l], state_gla[l],
                                           Ts, lam_init, *params)
        kp_list.append(kp)
        vp_list.append(vp)
        sp_list.append(sp)
        ks_list.append(k_s)
        vs_list.append(v_s)
        ss_list.append(s_s)
    return (y_p, y_s, jnp.stack(kp_list), jnp.stack(vp_list), jnp.stack(sp_list),
            jnp.stack(ks_list), jnp.stack(vs_list), jnp.stack(ss_list))
```

```cpp
#include <hip/hip_runtime.h>
#include <cstdio>
#include <cstdint>
namespace pg8 {
#define PG8_LAS __attribute__((address_space(3)))
typedef unsigned short bf16_t;
typedef short bf16x8 __attribute__((ext_vector_type(8)));
typedef float f32x4 __attribute__((ext_vector_type(4)));
typedef unsigned u32x4 __attribute__((ext_vector_type(4)));
constexpr int BM = 256, BK = 64, HALF = 128, HTB = HALF * BK * 2  , STAGE_BYTES = 8 * HTB, NXCD = 8, WGM = 8;

__host__ __device__ __forceinline__ int lds_byte(int r, int c) { const int st = (r >> 4) * 2 + (c >> 5), rr = r & 15, cc = c & 31, ob = rr * 64 + cc * 2; return st * 1024 + (ob ^ (((ob >> 9) & 1) << 5)); }
__host__ __device__ __forceinline__ void stage_rc(int b, int& R, int& C) { const int st = b / 1024, sb = b % 1024, swz = sb ^ (((sb >> 9) & 1) << 5); R = (st >> 1) * 16 + swz / 64; C = (st & 1) * 32 + (swz % 64) / 2; }
__host__ __device__ __forceinline__ int perm32(int rho) { const int n = rho >> 4, i = rho & 15; return 8 * (i >> 2) + 4 * n + (i & 3); }

struct Unit { int pm, pn, mask; };
struct Gemm { const bf16_t* A; const bf16_t* Bt; int M, N, K; };

struct StaticOrder {
    int nM, nN, nwg, G, c;
    __host__ __device__ void init(int M, int N, int G_, int c_) { nM = M / BM; nN = N / BM; nwg = nM * nN; G = G_; c = c_; }
    __host__ __device__ bool next(int i, Unit& u) const {
        const long L = (long)i * G + c; if (L >= nwg) return false;
        int wgid = (int)L; { const int q = nwg / NXCD, r = nwg % NXCD, xcd = wgid % NXCD, off = wgid / NXCD; wgid = (xcd < r ? xcd * (q + 1) : r * (q + 1) + (xcd - r) * q) + off; }
        const int nig = WGM * nN, gid = wgid / nig, fm = gid * WGM, gsz = (nM - fm) < WGM ? (nM - fm) : WGM;
        u.pm = fm + ((wgid % nig) % gsz); u.pn = (wgid % nig) / gsz; u.mask = 15; return true;
    }
    __device__ __forceinline__ void a_ready(const Unit&) const {}
    __device__ __forceinline__ void done(const Unit&) const {}
};

__device__ __forceinline__ unsigned cvt_pk_bf16(float lo, float hi) { unsigned r; asm volatile("v_cvt_pk_bf16_f32 %0, %1, %2" : "=v"(r) : "v"(lo), "v"(hi)); return r; }
typedef float f32x2 __attribute__((ext_vector_type(2)));
__device__ __forceinline__ f32x2 gelu_pk(f32x2 v) {
    const f32x2 av = __builtin_elementwise_abs(v), d = av * 0.2316418882f + 1.0f;
    f32x2 t; t.x = __builtin_amdgcn_rcpf(d.x); t.y = __builtin_amdgcn_rcpf(d.y);
    f32x2 q = t * 0.5307027145f + (-0.7265760135f); q = q * t + 0.7107068705f; q = q * t + (-0.142248368f); q = q * t + 0.127414796f; q = q * t;
    const f32x2 s = (v * v) * (-0.72134752044f);
    f32x2 e; e.x = __builtin_amdgcn_exp2f(s.x); e.y = __builtin_amdgcn_exp2f(s.y);
    const f32x2 m = v * (q * e), r = v - m;
    f32x2 o; o.x = v.x < 0.f ? m.x : r.x; o.y = v.y < 0.f ? m.y : r.y; return o;
}

template <int ACT  > struct EpiBf16 {
    static constexpr bool PERM = true, AFTER_DRAIN = false; static_assert(ACT == 0 || ACT == 1, "EpiBf16: ACT is 0 (none) or 1 (gelu_pk)");
    bf16_t* O; int ldc; const float* bias; int split_cols; size_t split_stride; float scale0;
    __device__ __forceinline__ void operator()(const f32x4 (&acc)[2][2][4][2], const Unit& u, int wr, int wc, int fr, int fq) const {
        const int row0 = u.pm * BM + wr * 64 + fr; int colt = u.pn * BM; bf16_t* base = O;
        float sc = 1.f; if (split_cols) { const int t = colt / split_cols; base += (size_t)t * split_stride; colt -= t * split_cols; if (t == 0) sc = scale0; }
        const int col0 = colt + wc * 32 + 8 * fq, bcol0 = u.pn * BM + wc * 32 + 8 * fq;
        f32x4 bv[2][2];
#pragma unroll
        for (int bj = 0; bj < 2; ++bj)
#pragma unroll
            for (int n = 0; n < 2; ++n) bv[bj][n] = bias ? *(const f32x4*)(bias + bcol0 + bj * HALF + 4 * n) : (f32x4){0.f, 0.f, 0.f, 0.f};
#pragma unroll
        for (int ai = 0; ai < 2; ++ai)
#pragma unroll
            for (int m = 0; m < 4; ++m) { bf16_t* rowp = base + (size_t)(row0 + ai * HALF + m * 16) * ldc + col0;
#pragma unroll
                for (int bj = 0; bj < 2; ++bj) { if (!((u.mask >> (2 * ai + bj)) & 1)) continue; f32x4 v0 = acc[ai][bj][m][0] + bv[bj][0], v1 = acc[ai][bj][m][1] + bv[bj][1];
                    if (ACT == 1) { f32x2 a = gelu_pk((f32x2){v0[0], v0[1]}), b = gelu_pk((f32x2){v0[2], v0[3]}), c = gelu_pk((f32x2){v1[0], v1[1]}), d = gelu_pk((f32x2){v1[2], v1[3]});
                        v0 = (f32x4){a.x, a.y, b.x, b.y}; v1 = (f32x4){c.x, c.y, d.x, d.y}; }
                    v0 = v0 * sc; v1 = v1 * sc; u32x4 w; w.x = cvt_pk_bf16(v0[0], v0[1]); w.y = cvt_pk_bf16(v0[2], v0[3]); w.z = cvt_pk_bf16(v1[0], v1[1]); w.w = cvt_pk_bf16(v1[2], v1[3]);
                    *(u32x4*)(rowp + bj * HALF) = w; } }
    }
};
typedef unsigned u32x2 __attribute__((ext_vector_type(2)));
struct EpiProj {
    static constexpr bool PERM = true, AFTER_DRAIN = false;
    bf16_t *QKV, *GB; float* GZ;
    float *outKp, *outKs, *outVp, *outVs; const float* rope;
    __device__ __forceinline__ void operator()(const f32x4 (&acc)[2][2][4][2], const Unit& u, int wr, int wc, int fr, int fq) const {
        const int pn = u.pn; const int row0 = u.pm * BM + wr * 64 + fr;
        if (pn < 16) {
            const bool isk = pn >= 8; const int hb = (pn & 7) * 256, i0 = 16 * wc + 4 * fq;
            bf16_t* dstb = QKV + (isk ? (size_t)16640 * 2048 : (size_t)0);
#pragma unroll
            for (int ai = 0; ai < 2; ++ai) {
                f32x4 rr0[4], rr1[4];
#pragma unroll
                for (int m = 0; m < 4; ++m) { const int row = row0 + ai * HALF + m * 16; const int pos = row < 16384 ? (row & 8191) : 1024 + ((row - 16384) & 15);
                    const f32x4* rp = (const f32x4*)(rope + (size_t)pos * 128 + 2 * i0); rr0[m] = rp[0]; rr1[m] = rp[1]; }
#pragma unroll
                for (int m = 0; m < 4; ++m) {
                    const int row = row0 + ai * HALF + m * 16;
                    const f32x4 r0 = rr0[m], r1 = rr1[m];
                    float* okrow = row < 16384 ? outKp + (size_t)row * 2048 : outKs + (size_t)(row - 16384) * 2048;
#pragma unroll
                    for (int bj = 0; bj < 2; ++bj) { if (!((u.mask >> (2 * ai + bj)) & 1)) continue;
                        const f32x4 v0 = acc[ai][bj][m][0], v1 = acc[ai][bj][m][1];
                        f32x4 lo, hi;
                        lo[0] = v0[0] * r0[0] - v0[1] * r0[1]; hi[0] = v0[1] * r0[0] + v0[0] * r0[1];
                        lo[1] = v0[2] * r0[2] - v0[3] * r0[3]; hi[1] = v0[3] * r0[2] + v0[2] * r0[3];
                        lo[2] = v1[0] * r1[0] - v1[1] * r1[1]; hi[2] = v1[1] * r1[0] + v1[0] * r1[1];
                        lo[3] = v1[2] * r1[2] - v1[3] * r1[3]; hi[3] = v1[3] * r1[2] + v1[2] * r1[3];
                        const int col = hb + bj * HALF + i0;
                        u32x2 wl, wh; wl.x = cvt_pk_bf16(lo[0], lo[1]); wl.y = cvt_pk_bf16(lo[2], lo[3]); wh.x = cvt_pk_bf16(hi[0], hi[1]); wh.y = cvt_pk_bf16(hi[2], hi[3]);
                        *(u32x2*)(dstb + (size_t)row * 2048 + col) = wl; *(u32x2*)(dstb + (size_t)row * 2048 + col + 64) = wh;
                        if (isk) { __builtin_nontemporal_store(lo, (f32x4*)(okrow + col)); __builtin_nontemporal_store(hi, (f32x4*)(okrow + col + 64)); }
                    }
                }
            }
        } else if (pn < 24) {
            const int col0 = (pn - 16) * 256 + wc * 32 + 8 * fq;
#pragma unroll
            for (int ai = 0; ai < 2; ++ai)
#pragma unroll
                for (int m = 0; m < 4; ++m) {
                    const int row = row0 + ai * HALF + m * 16;
                    float* ovrow = row < 16384 ? outVp + (size_t)row * 2048 : outVs + (size_t)(row - 16384) * 2048;
#pragma unroll
                    for (int bj = 0; bj < 2; ++bj) { if (!((u.mask >> (2 * ai + bj)) & 1)) continue;
                        const f32x4 v0 = acc[ai][bj][m][0], v1 = acc[ai][bj][m][1]; const int col = col0 + bj * HALF;
                        __builtin_nontemporal_store(v0, (f32x4*)(ovrow + col)); __builtin_nontemporal_store(v1, (f32x4*)(ovrow + col + 4));
                        u32x4 w; w.x = cvt_pk_bf16(v0[0], v0[1]); w.y = cvt_pk_bf16(v0[2], v0[3]); w.z = cvt_pk_bf16(v1[0], v1[1]); w.w = cvt_pk_bf16(v1[2], v1[3]);
                        *(u32x4*)(QKV + (size_t)2 * 16640 * 2048 + (size_t)row * 2048 + col) = w;
                    }
                }
        } else if (pn < 48) {
            size_t eoff; int ld, colt;
            if (pn < 28) { eoff = 0; ld = 1024; colt = (pn - 24) * 256; }
            else if (pn < 32) { eoff = (size_t)16640 * 1024; ld = 1024; colt = (pn - 28) * 256; }
            else if (pn < 40) { eoff = (size_t)16640 * 2048; ld = 2048; colt = (pn - 32) * 256; }
            else { eoff = (size_t)16640 * 4096; ld = 2048; colt = (pn - 40) * 256; }
            bf16_t* base = GB + eoff;
            const int col0 = colt + wc * 32 + 8 * fq;
#pragma unroll
            for (int ai = 0; ai < 2; ++ai)
#pragma unroll
                for (int m = 0; m < 4; ++m) {
                    const int row = row0 + ai * HALF + m * 16;
#pragma unroll
                    for (int bj = 0; bj < 2; ++bj) { if (!((u.mask >> (2 * ai + bj)) & 1)) continue;
                        const f32x4 v0 = acc[ai][bj][m][0], v1 = acc[ai][bj][m][1];
                        u32x4 w; w.x = cvt_pk_bf16(v0[0], v0[1]); w.y = cvt_pk_bf16(v0[2], v0[3]); w.z = cvt_pk_bf16(v1[0], v1[1]); w.w = cvt_pk_bf16(v1[2], v1[3]);
                        *(u32x4*)(base + (size_t)row * ld + col0 + bj * HALF) = w;
                    }
                }
        } else {
            if (wc == 0 && fq < 2) {
#pragma unroll
                for (int ai = 0; ai < 2; ++ai)
#pragma unroll
                    for (int m = 0; m < 4; ++m) { if (!((u.mask >> (2 * ai)) & 1)) continue;
                        const int row = row0 + ai * HALF + m * 16;
                        *(f32x4*)(GZ + (size_t)row * 16 + 8 * fq) = acc[ai][0][m][0]; *(f32x4*)(GZ + (size_t)row * 16 + 8 * fq + 4) = acc[ai][0][m][1];
                    }
            }
        }
    }
};
struct EpiMix {
    static constexpr bool PERM = false, AFTER_DRAIN = false;
    const float* xp; const float* xs; float* Y; float alpha;
    __device__ __forceinline__ void operator()(const f32x4 (&acc)[2][2][4][2], const Unit& u, int wr, int wc, int fr, int fq) const {
        const int row0 = u.pm * BM + wr * 64 + fr, col0 = u.pn * BM + wc * 32 + 4 * fq;
#pragma unroll
        for (int ai = 0; ai < 2; ++ai)
#pragma unroll
            for (int m = 0; m < 4; ++m) {
                const int row = row0 + ai * HALF + m * 16;
                const float* xr = row < 16384 ? xp + (size_t)row * 4096 : xs + (size_t)(row - 16384) * 4096;
                float* yr = Y + (size_t)row * 4096;
#pragma unroll
                for (int bj = 0; bj < 2; ++bj)
#pragma unroll
                    for (int n = 0; n < 2; ++n) { if (!((u.mask >> (2 * ai + bj)) & 1)) continue; const int c = col0 + bj * HALF + n * 16; const f32x4 xv = *(const f32x4*)(xr + c); *(f32x4*)(yr + c) = acc[ai][bj][m][n] + xv * alpha; }
            }
    }
};
template <class Epi, class Sched, bool ALIGN_EPI = false, bool SP2 = false>
__device__ __forceinline__ void gemm_phase(PG8_LAS unsigned char* lds, const Gemm g, const Sched& S, const Epi& E, int tid_in) {
    const int tid_ = tid_in;
    const int tid = tid_, wid = __builtin_amdgcn_readfirstlane(tid >> 6), lane = tid & 63, wr = wid >> 2, wc = wid & 3, fr = lane & 15, fq = lane >> 4;
    const int K = g.K, nt = K / BK;
    unsigned voffA[2], voffB[2];
#pragma unroll
    for (int i = 0; i < 2; ++i) { int R, C; stage_rc(tid * 16 + i * 8192, R, C); const int Rb = Epi::PERM ? ((R & ~31) + perm32(R & 31)) : R;
        voffA[i] = (unsigned)(R * K + C) * 2u; voffB[i] = (unsigned)(Rb * K + C) * 2u; }
    const size_t kstep = (size_t)(BK * 2);
    const size_t hstep = (size_t)HALF * K * 2;
    const size_t tstep = 2 * hstep;
    const unsigned ldsw = (unsigned)wid * 1024u;
    const int aoff = lds_byte(wr * 64 + fr, fq * 8), boff = lds_byte(wc * 32 + fr, fq * 8);
#define PG8_SA(b, h) (((b) * 2 + (h)) * HTB)
#define PG8_SB(b, h) ((4 + (b) * 2 + (h)) * HTB)
#define PG8_STAGE(bufoff, gbase, voff) do { _Pragma("unroll") for (int _i = 0; _i < 2; ++_i) \
        __builtin_amdgcn_global_load_lds((const unsigned*)((const char*)(gbase) + (voff)[_i]), (PG8_LAS unsigned*)(lds + (bufoff) + ldsw + _i * 8192), 16, 0, 0); } while (0)
#define PG8_LDA(dst, b, h) do { _Pragma("unroll") for (int m = 0; m < 4; ++m) _Pragma("unroll") for (int k = 0; k < 2; ++k) dst[m][k] = *(const PG8_LAS bf16x8*)(lds + PG8_SA(b, h) + aoff + m * 2048 + k * 1024); } while (0)
#define PG8_LDB(dst, b, h) do { _Pragma("unroll") for (int n = 0; n < 2; ++n) _Pragma("unroll") for (int k = 0; k < 2; ++k) dst[n][k] = *(const PG8_LAS bf16x8*)(lds + PG8_SB(b, h) + boff + n * 2048 + k * 1024); } while (0)
#define PG8_MMA(ai, bj, At, Bt) do { __builtin_amdgcn_s_setprio(1); _Pragma("unroll") for (int m = 0; m < 4; ++m) _Pragma("unroll") for (int n = 0; n < 2; ++n) _Pragma("unroll") for (int k = 0; k < 2; ++k) \
        acc[ai][bj][m][n] = __builtin_amdgcn_mfma_f32_16x16x32_bf16(Bt[n][k], At[m][k], acc[ai][bj][m][n], 0, 0, 0); __builtin_amdgcn_s_setprio(0); } while (0)
#define PG8_WAIT_V(n) asm volatile("s_waitcnt vmcnt(" #n ")" ::: "memory")
#define PG8_WAIT_L(n) asm volatile("s_waitcnt lgkmcnt(" #n ")" ::: "memory")
#define PG8_BAR __builtin_amdgcn_s_barrier()
#define PG8_SCHED __builtin_amdgcn_sched_barrier(0)
    Unit cur, nxt; int ui = 0;
    if (!S.next(0, cur)) return;
    f32x4 acc[2][2][4][2];
#pragma unroll
    for (int a = 0; a < 2; ++a)
#pragma unroll
        for (int b = 0; b < 2; ++b)
#pragma unroll
            for (int m = 0; m < 4; ++m)
#pragma unroll
                for (int n = 0; n < 2; ++n) acc[a][b][m][n] = (f32x4){0.f, 0.f, 0.f, 0.f};
    bf16x8 At[4][2], B0[2][2], B1[2][2];
    const char* cA = (const char*)g.A + (size_t)cur.pm * tstep; const char* cB = (const char*)g.Bt + (size_t)cur.pn * tstep;
    S.a_ready(cur);
    if constexpr (SP2) {
        PG8_STAGE(PG8_SB(0, 0), cB, voffB); PG8_STAGE(PG8_SB(0, 1), cB + hstep, voffB); PG8_STAGE(PG8_SA(0, 0), cA, voffA); PG8_STAGE(PG8_SA(0, 1), cA + hstep, voffA);
        if (wr == 1) PG8_BAR;
        PG8_WAIT_V(2); PG8_BAR;
        PG8_STAGE(PG8_SB(1, 0), cB + kstep, voffB); PG8_STAGE(PG8_SA(1, 0), cA + kstep, voffA); PG8_STAGE(PG8_SB(1, 1), cB + hstep + kstep, voffB);
        PG8_WAIT_V(6); PG8_BAR;
    } else {
        PG8_STAGE(PG8_SB(0, 0), cB, voffB); PG8_STAGE(PG8_SA(0, 0), cA, voffA); PG8_STAGE(PG8_SB(0, 1), cB + hstep, voffB); PG8_STAGE(PG8_SA(0, 1), cA + hstep, voffA);
        if (wr == 1) PG8_BAR;
        PG8_WAIT_V(4); PG8_BAR;
        PG8_STAGE(PG8_SB(1, 0), cB + kstep, voffB); PG8_STAGE(PG8_SA(1, 0), cA + kstep, voffA); PG8_STAGE(PG8_SB(1, 1), cB + hstep + kstep, voffB);
        PG8_WAIT_V(6); PG8_BAR;
    }
    for (;;) {
        const bool has_next = S.next(ui + 1, nxt);
        const char* nA = has_next ? (const char*)g.A + (size_t)nxt.pm * tstep : cA; const char* nB = has_next ? (const char*)g.Bt + (size_t)nxt.pn * tstep : cB;
        for (int t = 0; t < nt; t += 2) {
            const bool last = (t == nt - 2);
            const char* a1 = cA + (size_t)(t + 1) * kstep;
            const char* a2 = last ? nA : cA + (size_t)(t + 2) * kstep; const char* b2 = last ? nB : cB + (size_t)(t + 2) * kstep;
            const char* a3 = a2 + kstep; const char* b3 = b2 + kstep;
            if (last && has_next) S.a_ready(nxt);
            if constexpr (SP2) {
            PG8_LDB(B0, 0, 0); PG8_LDB(B1, 0, 1); PG8_SCHED; PG8_LDA(At, 0, 0); PG8_STAGE(PG8_SA(1, 1), a1 + hstep, voffA);
            PG8_WAIT_V(8); PG8_WAIT_L(0); PG8_BAR; PG8_MMA(0, 0, At, B0); PG8_MMA(0, 1, At, B1); PG8_BAR; PG8_SCHED;
            PG8_LDA(At, 0, 1); PG8_STAGE(PG8_SB(0, 0), b2, voffB); PG8_STAGE(PG8_SB(0, 1), b2 + hstep, voffB); PG8_STAGE(PG8_SA(0, 0), a2, voffA);
            PG8_WAIT_V(8); PG8_WAIT_L(0); PG8_BAR; PG8_MMA(1, 0, At, B0); PG8_MMA(1, 1, At, B1); PG8_BAR; PG8_SCHED;
            PG8_LDB(B0, 1, 0); PG8_LDB(B1, 1, 1); PG8_SCHED; PG8_LDA(At, 1, 0); PG8_STAGE(PG8_SA(0, 1), a2 + hstep, voffA);
            PG8_WAIT_V(8); PG8_WAIT_L(0); PG8_BAR; PG8_MMA(0, 0, At, B0); PG8_MMA(0, 1, At, B1); PG8_BAR; PG8_SCHED;
            PG8_LDA(At, 1, 1); PG8_STAGE(PG8_SB(1, 0), b3, voffB); PG8_STAGE(PG8_SB(1, 1), b3 + hstep, voffB); PG8_STAGE(PG8_SA(1, 0), a3, voffA);
            PG8_WAIT_V(8); PG8_WAIT_L(0); PG8_BAR; PG8_MMA(1, 0, At, B0); PG8_MMA(1, 1, At, B1); PG8_BAR; PG8_SCHED;
            } else {
            PG8_LDB(B0, 0, 0); PG8_SCHED; PG8_LDA(At, 0, 0); PG8_STAGE(PG8_SA(1, 1), a1 + hstep, voffA);
            PG8_WAIT_L(8); PG8_BAR; PG8_WAIT_L(0); PG8_MMA(0, 0, At, B0); PG8_BAR; PG8_SCHED;
            PG8_LDB(B1, 0, 1); PG8_STAGE(PG8_SB(0, 0), b2, voffB);
            PG8_BAR; PG8_WAIT_L(0); PG8_MMA(0, 1, At, B1); PG8_BAR;
            PG8_LDA(At, 0, 1); PG8_STAGE(PG8_SA(0, 0), a2, voffA);
            PG8_BAR; PG8_WAIT_L(0); PG8_MMA(1, 0, At, B0); PG8_BAR; PG8_SCHED;
            PG8_STAGE(PG8_SB(0, 1), b2 + hstep, voffB);
            PG8_WAIT_V(6); PG8_BAR; PG8_MMA(1, 1, At, B1); PG8_BAR;
            PG8_LDB(B0, 1, 0); PG8_SCHED; PG8_LDA(At, 1, 0); PG8_STAGE(PG8_SA(0, 1), a2 + hstep, voffA);
            PG8_WAIT_L(8); PG8_BAR; PG8_WAIT_L(0); PG8_MMA(0, 0, At, B0); PG8_BAR; PG8_SCHED;
            PG8_LDB(B1, 1, 1); PG8_STAGE(PG8_SB(1, 0), b3, voffB);
            PG8_BAR; PG8_WAIT_L(0); PG8_MMA(0, 1, At, B1); PG8_BAR;
            PG8_LDA(At, 1, 1); PG8_STAGE(PG8_SA(1, 0), a3, voffA);
            PG8_BAR; PG8_WAIT_L(0); PG8_MMA(1, 0, At, B0); PG8_BAR; PG8_SCHED;
            PG8_STAGE(PG8_SB(1, 1), b3 + hstep, voffB);
            PG8_WAIT_V(6); PG8_BAR; PG8_MMA(1, 1, At, B1); PG8_BAR;
            }
        }
        if constexpr (ALIGN_EPI) { if (wr == 0) PG8_BAR; }
        if constexpr (!Epi::AFTER_DRAIN) { E(acc, cur, wr, wc, fr, fq); S.done(cur); }
        if (!has_next) break;
#pragma unroll
        for (int a = 0; a < 2; ++a)
#pragma unroll
            for (int b = 0; b < 2; ++b)
#pragma unroll
                for (int m = 0; m < 4; ++m)
#pragma unroll
                    for (int n = 0; n < 2; ++n) acc[a][b][m][n] = (f32x4){0.f, 0.f, 0.f, 0.f};
        cur = nxt; cA = nA; cB = nB; ++ui;
        if constexpr (ALIGN_EPI) { if (wr == 1) PG8_BAR; }
    }
    PG8_WAIT_V(0);
    if constexpr (!ALIGN_EPI) { if (wr == 0) PG8_BAR; }
    PG8_BAR;
    if constexpr (Epi::AFTER_DRAIN) { E.fused(acc, cur, wr, wc, fr, fq, lds, wid, lane); S.done(cur); }
#undef PG8_SA
#undef PG8_SB
#undef PG8_STAGE
#undef PG8_LDA
#undef PG8_LDB
#undef PG8_MMA
#undef PG8_WAIT_V
#undef PG8_WAIT_L
#undef PG8_BAR
#undef PG8_SCHED
}
}
constexpr int DM = 4096, SEQ = 8192, TP = 16384, TSM = 256, MTOK = 16640;
constexpr int NPROJ = 12304, NPROJ_PAD = 12544;
constexpr int NWAVES = 8;
constexpr float ALPHA_RES = 1.189207115002721f, LN_EPS = 1e-5f, LAM_INIT = 0.2f;
constexpr size_t MiB = 1u << 20;
constexpr size_t WS_CTL = 0, CTL_ZERO_BYTES = 1 * MiB;
constexpr size_t WS_ROPE = 1 * MiB;
constexpr size_t WS_KEYB = 5 * MiB;
constexpr size_t WS_GZ   = 6 * MiB;
constexpr size_t WS_IDX  = 8 * MiB;
constexpr size_t WS_GATE = 17 * MiB;
constexpr size_t WS_WOUT = 26 * MiB;
constexpr size_t WS_WQ   = 58 * MiB;
constexpr size_t WS_A    = 74 * MiB;
constexpr size_t WS_B    = 204 * MiB;
constexpr size_t WS_QIN  = WS_B, WS_KENDT = WS_B + 32 * MiB, WS_AM = WS_B + 64 * MiB, WS_DEC = WS_B + 72 * MiB;
constexpr size_t WS_C    = 302 * MiB;
constexpr size_t WS_D    = 497 * MiB;
constexpr size_t WS_E    = 692 * MiB;
constexpr size_t WS_F    = 756 * MiB;
constexpr size_t WS_G    = 886 * MiB;
constexpr size_t WS_H    = 1146 * MiB;
constexpr size_t WS_END  = 1290 * MiB;
constexpr size_t SZ_TOK2048 = (size_t)MTOK * 2048 * 2;
constexpr int CW_TMO = 0, CW_QUEUE = 64, CW_BAR = 4096;
constexpr int LDS_BYTES = 163840, MISC_OFF = 159744;
constexpr size_t O_Y = 0, O_KP = 68157440, O_VP = 101711872, O_GP = 135266304, O_KS = 136314880, O_VS = 136839168, O_GS = 137363456;

#define GAS __attribute__((address_space(1)))
#define LAS __attribute__((address_space(3)))
typedef unsigned short bf16;
typedef unsigned v4u __attribute__((ext_vector_type(4)));
typedef unsigned v2u __attribute__((ext_vector_type(2)));
typedef float f32x4 __attribute__((ext_vector_type(4)));
typedef float f32x2 __attribute__((ext_vector_type(2)));
typedef float f32x16 __attribute__((ext_vector_type(16)));
typedef short bf16x8 __attribute__((ext_vector_type(8)));
typedef short s16x4 __attribute__((ext_vector_type(4)));
typedef __bf16 bf16x2_t __attribute__((ext_vector_type(2)));
typedef GAS unsigned gu32;
#define RLX_AGENT __ATOMIC_RELAXED, __HIP_MEMORY_SCOPE_AGENT
#define LDS_WAIT() asm volatile("s_waitcnt lgkmcnt(0)" ::: "memory")
#define VM_WAIT() asm volatile("s_waitcnt vmcnt(0)" ::: "memory")
__device__ __forceinline__ unsigned f2bf(float f) { unsigned u = __builtin_bit_cast(unsigned, f); return (u + 0x7fffu + ((u >> 16) & 1u)) >> 16; }
__device__ __forceinline__ unsigned pk2(float lo, float hi) { return f2bf(lo) | (f2bf(hi) << 16); }
__device__ __forceinline__ float bf2f(unsigned short b) { return __builtin_bit_cast(float, (unsigned)b << 16); }
__device__ __forceinline__ float bflo(unsigned w) { return __builtin_bit_cast(float, w << 16); }
__device__ __forceinline__ float bfhi(unsigned w) { return __builtin_bit_cast(float, w & 0xffff0000u); }
__device__ __forceinline__ int lane_id_v() { int l; asm volatile("v_mbcnt_lo_u32_b32 %0, -1, 0\n\tv_mbcnt_hi_u32_b32 %0, -1, %0" : "=v"(l)); return l; }
template <int CTRL> __device__ __forceinline__ float dppf(float v) { return __builtin_bit_cast(float, __builtin_amdgcn_update_dpp(0, __builtin_bit_cast(int, v), CTRL, 0xF, 0xF, true)); }
__device__ __forceinline__ float xor1(float v) { return dppf<0xB1>(v); }
__device__ __forceinline__ float xor2(float v) { return dppf<0x4E>(v); }
__device__ __forceinline__ float xor4s(float v) { return dppf<0x141>(v); }
__device__ __forceinline__ float xor8(float v) { return dppf<0x128>(v); }
__device__ __forceinline__ float xor16(float v) { return __builtin_bit_cast(float, __builtin_amdgcn_ds_swizzle(__builtin_bit_cast(int, v), 0x401F)); }
__device__ __forceinline__ float wave_sum(float v) {
    v += xor1(v); v += xor2(v); v += xor4s(v); v += xor8(v); v += xor16(v);
    const auto rr = __builtin_amdgcn_permlane32_swap(__float_as_uint(v), __float_as_uint(v), false, false); return __uint_as_float(rr[0]) + __uint_as_float(rr[1]);
}
__device__ __forceinline__ int crow(int r, int hi) { return (r & 3) + 8 * (r >> 2) + 4 * hi; }
#define MFMA32(a, b, c) __builtin_amdgcn_mfma_f32_32x32x16_bf16((a), (b), (c), 0, 0, 0)
#define XB_TMO      128
#define XB_XCNT(j)  (256  + 64 * (j))
#define XB_XSUB(j)  (1280 + 64 * (j))
#define XB_XGEN(j)  (2304 + 64 * (j))
#define XB_TOP      3328
#define XB_TOPGEN   3392
#define XCD_BAR_WORDS 3456
#define XB_SPIN_CAP (1u << 18)

__device__ __forceinline__ unsigned xb_ld(unsigned* p)              { return __hip_atomic_load(p, __ATOMIC_RELAXED, __HIP_MEMORY_SCOPE_AGENT); }
__device__ __forceinline__ unsigned xb_add(unsigned* p, unsigned v) { return __hip_atomic_fetch_add(p, v, __ATOMIC_RELAXED, __HIP_MEMORY_SCOPE_AGENT); }
__device__ __forceinline__ unsigned xb_xcc_id() { return (unsigned)__builtin_amdgcn_s_getreg((3 << 11) | 20) & 0xFu; }
#define XB_SPIN(cond, bar) do { unsigned _sp = 0; while (cond) { __builtin_amdgcn_s_sleep(1); \
    if ((++_sp & 255u) == 0u) { if (xb_ld(&(bar)[XB_TMO])) break; if (_sp > XB_SPIN_CAP) { atomicAdd(&(bar)[XB_TMO], 1u); break; } } } } while (0)

struct XcdBarrier {
    unsigned* bar; unsigned x; unsigned wv;
    volatile LAS unsigned* st;
};

__device__ __forceinline__ XcdBarrier xcd_barrier_post(unsigned* bar, volatile LAS unsigned* st) {
    XcdBarrier b; b.bar = bar; b.x = xb_xcc_id(); b.st = st;
    if (threadIdx.x == 0) (void)xb_add(&bar[XB_XCNT(b.x)], 1u);
    b.wv = (unsigned)__builtin_amdgcn_readfirstlane((int)(threadIdx.x >> 6));
    return b;
}
__device__ __forceinline__ void xcd_barrier_complete(unsigned* bar, unsigned x, unsigned& nloc, unsigned& nx) {
    const unsigned G = gridDim.x * gridDim.y * gridDim.z;
    unsigned sum, cnt, mine, sp = 0u;
    for (;;) {
        sum = 0u; cnt = 0u; mine = 0u;
#pragma unroll
        for (unsigned j = 0; j < 16; ++j) { const unsigned c = xb_ld(&bar[XB_XCNT(j)]); sum += c; cnt += (c > 0u) ? 1u : 0u; mine = (j == x) ? c : mine; }
        if (sum == G) break;
        __builtin_amdgcn_s_sleep(1);
        if ((++sp & 255u) == 0u) { if (xb_ld(&bar[XB_TMO])) break; if (sp > XB_SPIN_CAP) { atomicAdd(&bar[XB_TMO], 1u); break; } }
    }
    nloc = mine > 0u ? mine : 1u; nx = cnt > 0u ? cnt : 1u;
}

__device__ __forceinline__ void xcd_barrier(const XcdBarrier& b) {
    asm volatile("s_waitcnt vmcnt(0)" ::: "memory");
    __syncthreads();
    if (b.wv == 0u && lane_id_v() == 0) {
        unsigned* bar = b.bar;
        __builtin_amdgcn_s_waitcnt(0);
        unsigned nloc = b.st[0], nx = b.st[1];
        if (nloc == 0u) { xcd_barrier_complete(bar, b.x, nloc, nx); b.st[0] = nloc; b.st[1] = nx; }
        const unsigned old = xb_add(&bar[XB_XSUB(b.x)], 1u);
        const unsigned gen = old / nloc;
        if (old + 1u == (gen + 1u) * nloc) {
            __builtin_amdgcn_fence(__ATOMIC_RELEASE, "agent");
            asm volatile("s_waitcnt vmcnt(0)" ::: "memory");
            const unsigned og = xb_add(&bar[XB_TOP], 1u);
            const unsigned tg = og / nx;
            if (og + 1u == (tg + 1u) * nx) xb_add(&bar[XB_TOPGEN], 1u);
            else XB_SPIN(xb_ld(&bar[XB_TOPGEN]) == tg, bar);
            __builtin_amdgcn_fence(__ATOMIC_ACQUIRE, "agent");
            xb_add(&bar[XB_XGEN(b.x)], 1u);
            asm volatile("s_waitcnt vmcnt(0)" ::: "memory");
        } else {
            XB_SPIN(xb_ld(&bar[XB_XGEN(b.x)]) == gen, bar);
            __builtin_amdgcn_fence(__ATOMIC_ACQUIRE, "agent");
            asm volatile("s_waitcnt vmcnt(0)" ::: "memory");
        }
    }
    __syncthreads();
}
struct Frame {
    unsigned char* lds;
    gu32* ctl;
    int wave, G, bid;
    unsigned char* ws; float* out;
    const float *x_p, *x_s, *cache_k, *cache_v, *state, *w_in, *w_gate2, *b_gate, *lq1, *lk1, *lq2, *lk2, *dng, *gng, *w_out, *ln1g, *ln1b, *ln2g, *ln2b, *peer_wq, *keys1, *keys2, *peer_u, *peer_v;
};

template <int MODE>
__device__ __forceinline__ void p0_transpose_item(const float* W, int K, int N, bf16* WT, float* scr, int kb, int nb, int lane) {
    const int k0 = 64 * kb, n0 = 64 * nb; const int nc = n0 + lane; const bool okc = nc < N;
    float v[64];
#pragma unroll
    for (int i = 0; i < 64; ++i) v[i] = okc ? W[(size_t)(k0 + i) * N + nc] : 0.f;
#pragma unroll
    for (int i = 0; i < 64; ++i) scr[i * 65 + lane] = v[i];
    LDS_WAIT(); asm volatile("" ::: "memory");
    const int c = lane & 7;
#pragma unroll
    for (int j = 0; j < 8; ++j) { const int n = (lane >> 3) + 8 * j; const float* s = scr + (8 * c) * 65 + n; const int gn = n0 + n;
        v4u o; o.x = pk2(s[0 * 65], s[1 * 65]); o.y = pk2(s[2 * 65], s[3 * 65]); o.z = pk2(s[4 * 65], s[5 * 65]); o.w = pk2(s[6 * 65], s[7 * 65]);
        int dr = gn;
        if (MODE == 1 && gn < 4096) { const int jj = gn & 127; dr = (gn & ~127) + (jj < 64 ? 2 * jj : 2 * (jj - 64) + 1); }
        if (gn < N) *(v4u*)(WT + (size_t)dr * K + k0 + 8 * c) = o; }
    LDS_WAIT(); asm volatile("" ::: "memory");
}
__device__ __forceinline__ void cvt8(const float* src, bf16* dst) {
    const f32x4 a = *(const f32x4*)src, b = *(const f32x4*)(src + 4);
    v4u o; o.x = pk2(a[0], a[1]); o.y = pk2(a[2], a[3]); o.z = pk2(b[0], b[1]); o.w = pk2(b[2], b[3]);
    *(v4u*)dst = o;
}
__device__ __forceinline__ void cvt_stream(const float* src, bf16* dst, size_t n8, size_t gt, size_t ngt) {
    size_t i = gt;
    for (; i + 3 * ngt < n8; i += 4 * ngt) {
        f32x4 a[4], b[4];
#pragma unroll
        for (int k = 0; k < 4; ++k) { a[k] = *(const f32x4*)(src + (i + k * ngt) * 8); b[k] = *(const f32x4*)(src + (i + k * ngt) * 8 + 4); }
#pragma unroll
        for (int k = 0; k < 4; ++k) { v4u o; o.x = pk2(a[k][0], a[k][1]); o.y = pk2(a[k][2], a[k][3]); o.z = pk2(b[k][0], b[k][1]); o.w = pk2(b[k][2], b[k][3]); *(v4u*)(dst + (i + k * ngt) * 8) = o; }
    }
    for (; i < n8; i += ngt) cvt8(src + i * 8, dst + i * 8);
}
__device__ __forceinline__ void cvt_cache_unit(Frame& F, int u) {
    bf16* KSB = (bf16*)(F.ws + WS_H); bf16* VSB = (bf16*)(F.ws + WS_H + 72 * MiB); const int tid = F.wave * 64 + lane_id_v();
    if (u < 128) { const int sb = u >> 3, r0 = 128 * (u & 7);
        const float* ck = F.cache_k + ((size_t)sb * 1024 + r0) * 2048; const float* cv = F.cache_v + ((size_t)sb * 1024 + r0) * 2048; const size_t d0 = ((size_t)sb * 1152 + r0) * 2048;
        for (int k = tid; k < 128 * 256; k += 512) { cvt8(ck + (size_t)k * 8, KSB + d0 + (size_t)k * 8); cvt8(cv + (size_t)k * 8, VSB + d0 + (size_t)k * 8); } }
    else { const int sb = u - 128; const size_t d0 = ((size_t)sb * 1152 + 1040) * 2048;
        for (int k = tid; k < 112 * 256; k += 512) { *(v4u*)(KSB + d0 + (size_t)k * 8) = (v4u){0u, 0u, 0u, 0u}; *(v4u*)(VSB + d0 + (size_t)k * 8) = (v4u){0u, 0u, 0u, 0u}; } }
}
__device__ __forceinline__ void cvt_cache_drain(Frame& F, int max_units) {
    volatile unsigned* slot = (volatile unsigned*)(F.lds + MISC_OFF + 64);
    for (int n = 0; n < max_units; ++n) {
        __syncthreads();
        if ((F.wave * 64 + lane_id_v()) == 0) *slot = __hip_atomic_fetch_add((unsigned*)(F.ctl + CW_QUEUE + 64 * 9), 1u, __ATOMIC_RELAXED, __HIP_MEMORY_SCOPE_AGENT);
        __syncthreads();
        const int u = __builtin_amdgcn_readfirstlane((int)*slot);
        if (u >= 144) break;
        cvt_cache_unit(F, u);
    }
}
__device__ __forceinline__ void p0_prologue(Frame& F) {
    float* scr = (float*)(F.lds + F.wave * 16640);
    const int gw = F.bid * NWAVES + F.wave, NGW = F.G * NWAVES;
    const size_t gt = (size_t)F.bid * 512 + (F.wave * 64 + lane_id_v()), ngt = (size_t)F.G * 512;
    bf16* XB = (bf16*)(F.ws + WS_A); bf16* WIN_T = (bf16*)(F.ws + WS_B); bf16* WOUT_T = (bf16*)(F.ws + WS_WOUT); bf16* WQ_T = (bf16*)(F.ws + WS_WQ);
    constexpr int I_IN = 64 * 193, I_OUT = 64 * 64, I_Q = 64 * 32;
    for (int it = gw; it < I_IN + I_OUT + I_Q; it += NGW) {
        int r = it;
        if (r < I_IN) { p0_transpose_item<1>(F.w_in, DM, NPROJ, WIN_T, scr, r / 193, r % 193, lane_id_v()); continue; } r -= I_IN;
        if (r < I_OUT) { p0_transpose_item<0>(F.w_out, DM, DM, WOUT_T, scr, r / 64, r % 64, lane_id_v()); continue; } r -= I_OUT;
        p0_transpose_item<0>(F.peer_wq, DM, 2048, WQ_T, scr, r / 32, r % 32, lane_id_v());
    }
    { const size_t n16 = (size_t)(NPROJ_PAD - NPROJ) * DM * 2 / 16; v4u* z = (v4u*)(WIN_T + (size_t)NPROJ * DM);
      for (size_t i = gt; i < n16; i += ngt) z[i] = (v4u){0u, 0u, 0u, 0u}; }
    cvt_stream(F.x_p, XB, (size_t)TP * DM / 8, gt, ngt);
    cvt_stream(F.x_s, XB + (size_t)TP * DM, (size_t)TSM * DM / 8, gt, ngt);
    cvt_stream(F.keys1, (bf16*)(F.ws + WS_KEYB), (size_t)8 * 128 * 128 / 8, gt, ngt);
    cvt_stream(F.keys2, (bf16*)(F.ws + WS_KEYB) + 8 * 128 * 128, (size_t)8 * 128 * 128 / 8, gt, ngt);
    { float* rope = (float*)(F.ws + WS_ROPE);
      for (size_t idx = gt; idx < (size_t)8192 * 64; idx += ngt) {
          const int pos = (int)(idx >> 6), i = (int)(idx & 63);
          double inv = 1.0;
          if (i & 1) inv *= 0.8659643233600653; if (i & 2) inv *= 0.7498942093324558; if (i & 4) inv *= 0.5623413251903491;
          if (i & 8) inv *= 0.31622776601683794; if (i & 16) inv *= 0.09999999999999999; if (i & 32) inv *= 0.009999999999999998;
          const float invf = (float)inv; const float angf = (float)pos * invf; const double a = (double)angf;
          const double n = __builtin_rint(a * 0.15915494309189535); const double rr = __builtin_fma(-n, 6.283185307179586, a);
          const double kq = __builtin_rint(rr * 0.6366197723675814); const double y = __builtin_fma(-kq, 1.5707963267948966, rr); const double y2 = y * y;
          double s = 1.0 / 6227020800.0;
          s = s * y2 - 1.0 / 39916800.0; s = s * y2 + 1.0 / 362880.0; s = s * y2 - 1.0 / 5040.0; s = s * y2 + 1.0 / 120.0; s = s * y2 - 1.0 / 6.0; s = s * y2 + 1.0; s = s * y;
          double c = -1.0 / 87178291200.0;
          c = c * y2 + 1.0 / 479001600.0; c = c * y2 - 1.0 / 3628800.0; c = c * y2 + 1.0 / 40320.0; c = c * y2 - 1.0 / 720.0; c = c * y2 + 1.0 / 24.0; c = c * y2 - 0.5; c = c * y2 + 1.0;
          const int q = ((int)kq) & 3; double cs, sn;
          if (q == 0) { sn = s; cs = c; } else if (q == 1) { sn = c; cs = -s; } else if (q == 2) { sn = -s; cs = -c; } else { sn = -c; cs = s; }
          rope[idx * 2] = (float)cs; rope[idx * 2 + 1] = (float)sn;
      } }
}
__device__ __forceinline__ float log_sigmoid_f(float z) { return fminf(z, 0.f) - __logf(1.f + __expf(-fabsf(z))); }
__device__ __forceinline__ int qin_slot(int ch) { const int c = ch & 15; return (ch & ~15) + ((c >= 4 && c < 12) ? (c ^ 12) : c); }
__device__ __forceinline__ void gla_prep_prompt(Frame& F, int item) {
    const int c = item & 127, h = (item >> 7) & 3, b = item >> 9; const int m0 = b * SEQ + 64 * c;
    float* bc = (float*)F.lds;
    bf16* qs = (bf16*)(F.lds + 65536);
    bf16* ks = (bf16*)(F.lds + 65536 + 33792);
    float* gzs = (float*)(F.lds + 65536 + 2 * 33792);
    const float* GZ = (const float*)(F.ws + WS_GZ);
    const bf16* GQ = (const bf16*)(F.ws + WS_D); const bf16* GK = (const bf16*)(F.ws + WS_D + SZ_TOK2048 / 2); const bf16* GV = (const bf16*)(F.ws + WS_D + SZ_TOK2048);
    bf16* QIN = (bf16*)(F.ws + WS_QIN) + (size_t)item * 64 * 256; bf16* KENDT = (bf16*)(F.ws + WS_KENDT) + (size_t)item * 256 * 64;
    bf16* AM = (bf16*)(F.ws + WS_AM) + (size_t)item * 4096; float* DEC = (float*)(F.ws + WS_DEC) + (size_t)item * 256; bf16* VT = (bf16*)(F.ws + WS_E) + (size_t)item * 512 * 64;
    const int t = (F.wave * 64 + lane_id_v()), ch = t & 255, th = t >> 8;
    v4u vpre[8];
#pragma unroll
    for (int i = 0; i < 8; ++i) { const int p = t + 512 * i, tok = p >> 6, c8 = p & 63; vpre[i] = *(const v4u*)(GV + (size_t)(m0 + tok) * 2048 + h * 512 + 8 * c8); }
    __syncthreads();
    for (int i = t; i < 1024; i += 512) gzs[i] = GZ[(size_t)(m0 + (i >> 4)) * 16 + (i & 15)];
    float wg[16];
#pragma unroll
    for (int k = 0; k < 16; ++k) wg[k] = F.w_gate2[k * 1024 + h * 256 + ch];
    const float bias = F.b_gate[h * 256 + ch];
    __syncthreads();
    float run = 0.f;
    for (int tt = 0; tt < 32; ++tt) { const int tok = 32 * th + tt; float z = bias;
#pragma unroll
        for (int k = 0; k < 16; ++k) z = fmaf(gzs[tok * 16 + k], wg[k], z);
        run += log_sigmoid_f(z) * 0.0625f; bc[tok * 256 + ch] = run; }
    __syncthreads();
    const float b31 = bc[31 * 256 + ch]; const float btot = b31 + bc[63 * 256 + ch]; const float offs = th ? b31 : 0.f;
#pragma unroll 1
    for (int j4 = 0; j4 < 4; ++j4) {
        unsigned short qv[8], kv[8];
#pragma unroll
        for (int e = 0; e < 8; ++e) { const int tok = 32 * th + 8 * j4 + e; qv[e] = GQ[(size_t)(m0 + tok) * 1024 + h * 256 + ch]; kv[e] = GK[(size_t)(m0 + tok) * 1024 + h * 256 + ch]; }
        unsigned kp[4];
#pragma unroll
        for (int e2 = 0; e2 < 4; ++e2) {
            float ke[2];
#pragma unroll
            for (int e = 0; e < 2; ++e) { const int tok = 32 * th + 8 * j4 + 2 * e2 + e; const float bb = bc[tok * 256 + ch] + offs;
                const float q = bf2f(qv[2 * e2 + e]), k = bf2f(kv[2 * e2 + e]);
                const float qin = q * __expf(bb) * 0.0625f, kin = k * __expf(-bb); ke[e] = k * __expf(btot - bb);
                const unsigned short qb = (unsigned short)f2bf(qin);
                qs[tok * 264 + ch] = qb; ks[tok * 264 + ch] = (unsigned short)f2bf(kin);
                { const int sl = qin_slot(ch); QIN[tok * 256 + ((((sl >> 3) ^ (tok & 31)) << 3) | (sl & 7))] = qb; } }
            kp[e2] = pk2(ke[0], ke[1]);
        }
        *(v4u*)(KENDT + ch * 64 + (((4 * th + j4) ^ ((ch >> 1) & 7)) << 3)) = (v4u){kp[0], kp[1], kp[2], kp[3]};
    }
    if (th == 0) DEC[ch] = __expf(btot);
    __syncthreads();
    if (F.wave < 4) {
        const int tt = F.wave >> 1, ss = F.wave & 1, r32 = lane_id_v() & 31, hi = lane_id_v() >> 5;
        f32x16 d = {};
        if (!(tt == 0 && ss == 1)) {
#pragma unroll
            for (int kk = 0; kk < 16; ++kk) {
                const bf16x8 a = *(const bf16x8*)(qs + (32 * tt + r32) * 264 + 16 * kk + 8 * hi);
                const bf16x8 bq = *(const bf16x8*)(ks + (32 * ss + r32) * 264 + 16 * kk + 8 * hi);
                d = MFMA32(a, bq, d);
            }
        }
#pragma unroll
        for (int r = 0; r < 16; ++r) { const int ta = 32 * tt + crow(r, hi), sa = 32 * ss + r32; AM[ta * 64 + ((((sa >> 3) ^ ((ta >> 1) & 7)) << 3) | (sa & 7))] = (unsigned short)f2bf(sa <= ta ? d[r] : 0.f); }
    }
    __syncthreads();
    bf16* vs = (bf16*)F.lds;
#pragma unroll
    for (int i = 0; i < 8; ++i) { const int p = t + 512 * i, tok = p >> 6, c8 = p & 63; *(v4u*)(vs + tok * 520 + 8 * c8) = vpre[i]; }
    __syncthreads();
    { const int dv = t;
#pragma unroll
      for (int g = 0; g < 8; ++g) { unsigned w[4];
#pragma unroll
          for (int j = 0; j < 4; ++j) w[j] = (unsigned)vs[(8 * g + 2 * j) * 520 + dv] | ((unsigned)vs[(8 * g + 2 * j + 1) * 520 + dv] << 16);
          *(v4u*)(VT + dv * 64 + 8 * g) = (v4u){w[0], w[1], w[2], w[3]}; } }
}
__device__ __forceinline__ void sample_kv_copy(Frame& F, int item) {
    const int h = item & 3, sb = item >> 2; const int m0 = TP + sb * 16; const int t = (F.wave * 64 + lane_id_v());
    { const bf16* KB = (const bf16*)(F.ws + WS_C + SZ_TOK2048); const bf16* VB = (const bf16*)(F.ws + WS_C + 2 * SZ_TOK2048);
      bf16* KSB = (bf16*)(F.ws + WS_H); bf16* VSB = (bf16*)(F.ws + WS_H + 72 * MiB);
      const int row = t >> 5, pc = t & 31;
#pragma unroll
      for (int hh = 0; hh < 2; ++hh) { const size_t src = (size_t)(m0 + row) * 2048 + (h + 4 * hh) * 256 + 8 * pc, dst = ((size_t)sb * 1152 + 1024 + row) * 2048 + (h + 4 * hh) * 256 + 8 * pc;
          *(v4u*)(KSB + dst) = *(const v4u*)(KB + src); *(v4u*)(VSB + dst) = *(const v4u*)(VB + src); } }
}
__device__ __forceinline__ void gla_sample_item(Frame& F, int item) {
    const int h = item & 3, sb = item >> 2; const int m0 = TP + sb * 16;
    float* qT = (float*)F.lds;
    float* kT = qT + 4096;
    float* kin = kT + 4096;
    float* qn = kin + 4096;
    float* Am = qn + 4096;
    float* dec = Am + 256;
    float* gzs = dec + 256;
    const float* GZ = (const float*)(F.ws + WS_GZ);
    const bf16* GQ = (const bf16*)(F.ws + WS_D); const bf16* GK = (const bf16*)(F.ws + WS_D + SZ_TOK2048 / 2); const bf16* GV = (const bf16*)(F.ws + WS_D + SZ_TOK2048);
    bf16* MIXIN = (bf16*)(F.ws + WS_F);
    const int t = (F.wave * 64 + lane_id_v());
    __syncthreads();
    if (t < 256) gzs[t] = GZ[(size_t)(m0 + (t >> 4)) * 16 + (t & 15)];
    __syncthreads();
    if (t < 256) {
        const int ch = t; float wg[16];
#pragma unroll
        for (int k = 0; k < 16; ++k) wg[k] = F.w_gate2[k * 1024 + h * 256 + ch];
        const float bias = F.b_gate[h * 256 + ch];
        float bb[16]; float run = 0.f;
#pragma unroll
        for (int tok = 0; tok < 16; ++tok) { float z = bias;
#pragma unroll
            for (int k = 0; k < 16; ++k) z = fmaf(gzs[tok * 16 + k], wg[k], z);
            run += log_sigmoid_f(z) * 0.0625f; bb[tok] = run; }
        const float btot = run;
#pragma unroll
        for (int tok = 0; tok < 16; ++tok) {
            const float q = bf2f(GQ[(size_t)(m0 + tok) * 1024 + h * 256 + ch]), k = bf2f(GK[(size_t)(m0 + tok) * 1024 + h * 256 + ch]);
            const float qi = q * __expf(bb[tok]) * 0.0625f;
            qT[ch * 16 + tok] = qi; qn[tok * 256 + ch] = qi; kin[tok * 256 + ch] = k * __expf(-bb[tok]); kT[ch * 16 + tok] = k * __expf(btot - bb[tok]); }
        dec[ch] = __expf(btot);
    }
    __syncthreads();
    if (t < 256) { const int ti = t >> 4, si = t & 15; float a = 0.f;
        if (si <= ti) { for (int chh = 0; chh < 256; ++chh) a = fmaf(qn[ti * 256 + chh], kin[si * 256 + chh], a); }
        Am[ti * 16 + si] = a; }
    __syncthreads();
    { const int dv = t; float v[16], o[16];
#pragma unroll
      for (int s = 0; s < 16; ++s) v[s] = bf2f(GV[(size_t)(m0 + s) * 2048 + h * 512 + dv]);
#pragma unroll
      for (int ti = 0; ti < 16; ++ti) { float a = 0.f;
#pragma unroll
          for (int s = 0; s < 16; ++s) a = fmaf(Am[ti * 16 + s], v[s], a);
          o[ti] = a; }
      const float* S0 = F.state + ((size_t)(sb * 4 + h) * 256) * 512 + dv; float* S1 = F.out + O_GS + ((size_t)(sb * 4 + h) * 256) * 512 + dv;
      for (int chh = 0; chh < 256; ++chh) {
          const float s0 = S0[(size_t)chh * 512];
          const f32x4* qp = (const f32x4*)(qT + chh * 16); const f32x4* kp = (const f32x4*)(kT + chh * 16);
          float sn = dec[chh] * s0;
#pragma unroll
          for (int j = 0; j < 4; ++j) { const f32x4 qv = qp[j], kv = kp[j];
#pragma unroll
              for (int e = 0; e < 4; ++e) { o[4 * j + e] = fmaf(qv[e], s0, o[4 * j + e]); sn = fmaf(kv[e], v[4 * j + e], sn); } }
          S1[(size_t)chh * 512] = sn;
      }
#pragma unroll
      for (int ti = 0; ti < 16; ++ti) MIXIN[(size_t)(m0 + ti) * 4096 + 2048 + h * 512 + dv] = (unsigned short)f2bf(o[ti]);
    }
}
__device__ __forceinline__ void p2_gla_prep(Frame& F) {
    for (int it = F.bid; it < 1024 + 64; it += F.G) { if (it < 1024) gla_prep_prompt(F, it); else sample_kv_copy(F, it - 1024); }
}
namespace att {
constexpr int D = 128, NW = 8, QBLK = 32, KVBLK = 64;
constexpr float SCALE = 0.088388347648318440f, THR = 8.f;
constexpr int LDQ = 2048, LDK = 2048, LDO = 1024;
constexpr size_t SHM_V = KVBLK * D * 2, SHM_K = KVBLK * D * 2, SHM_ATTN = 2 * SHM_V + 2 * SHM_K + NW * 64 * 4;
#define KSWZ(row, colB) ((row) * 256 + ((colB) ^ (((row) & 7) << 4)))
#define SBAR() __builtin_amdgcn_sched_barrier(0)
__device__ __forceinline__ unsigned cvtpk(float lo, float hi) { unsigned r; asm volatile("v_cvt_pk_bf16_f32 %0, %1, %2" : "=v"(r) : "v"(lo), "v"(hi)); return r; }
__device__ __forceinline__ void partialSM(f32x16& p0, f32x16& p1, float& m_reg, float& mn, float& alpha, int rem, int hi) {
  constexpr float C = SCALE * 1.4426950408889634f;
  if (rem < 64) {
#pragma unroll
    for (int r = 0; r < 16; ++r) { if (8 * (r >> 2) >= rem) p0[r] = -1e30f; if (32 + 8 * (r >> 2) >= rem) p1[r] = -1e30f; }
  }
  float pmax = p0[0];
#pragma unroll
  for (int r = 1; r < 16; ++r) pmax = fmaxf(pmax, p0[r]);
#pragma unroll
  for (int r = 0; r < 16; ++r) pmax = fmaxf(pmax, p1[r]);
  { auto rr = __builtin_amdgcn_permlane32_swap(__float_as_uint(pmax), __float_as_uint(pmax), false, false);
    pmax = fmaxf(__uint_as_float(rr[0]), __uint_as_float(rr[1])); }
  if (__builtin_expect(__all(pmax - m_reg <= THR / SCALE), 1)) { mn = m_reg; alpha = 1.f; }
  else { mn = fmaxf(m_reg, pmax); alpha = __builtin_amdgcn_exp2f((m_reg - mn) * C); m_reg = mn; }
  float mnC = -mn * C;
#pragma unroll
  for (int r = 0; r < 16; ++r) p0[r] = fmaf(p0[r], C, mnC);
#pragma unroll
  for (int r = 0; r < 16; ++r) p1[r] = fmaf(p1[r], C, mnC);
#pragma unroll
  for (int r = 0; r < 16; ++r) p0[r] = __builtin_amdgcn_exp2f(p0[r]);
}
__device__ __forceinline__ void finishSM(f32x16& p0, f32x16& p1, float alpha, float& l_reg, bf16x8& pa0, bf16x8& pa1, bf16x8& pa2, bf16x8& pa3) {
#pragma unroll
  for (int r = 0; r < 16; ++r) p1[r] = __builtin_amdgcn_exp2f(p1[r]);
  float ps = 0;
#pragma unroll
  for (int r = 0; r < 16; ++r) ps += p0[r];
#pragma unroll
  for (int r = 0; r < 16; ++r) ps += p1[r];
  { auto rr = __builtin_amdgcn_permlane32_swap(__float_as_uint(ps), __float_as_uint(ps), false, false);
    ps = __uint_as_float(rr[0]) + __uint_as_float(rr[1]); }
  l_reg = l_reg * alpha + ps;
#define PK4(P, BASE, OUT) do { unsigned a0 = cvtpk(P[BASE + 0], P[BASE + 1]), a1 = cvtpk(P[BASE + 2], P[BASE + 3]);   \
    unsigned b0 = cvtpk(P[BASE + 4], P[BASE + 5]), b1 = cvtpk(P[BASE + 6], P[BASE + 7]);                              \
    auto r0 = __builtin_amdgcn_permlane32_swap(a0, b0, false, false); auto r1 = __builtin_amdgcn_permlane32_swap(a1, b1, false, false); \
    v4u w = {r0[0], r1[0], r0[1], r1[1]}; OUT = *reinterpret_cast<bf16x8*>(&w); } while (0)
  PK4(p0, 0, pa0); PK4(p0, 8, pa1); PK4(p1, 0, pa2); PK4(p1, 8, pa3);
#undef PK4
}
__device__ __forceinline__ void qkt(f32x16& p0, f32x16& p1, const bf16* Ks, const bf16x8* qr, int r32, int hi) {
  p0 = f32x16{}; p1 = f32x16{};
#pragma unroll
  for (int d0 = 0; d0 < 8; ++d0) { int cb = (d0 * 16 + hi * 8) * 2;
    bf16x8 b0 = *reinterpret_cast<const bf16x8*>((const char*)Ks + KSWZ(r32, cb));
    bf16x8 b1 = *reinterpret_cast<const bf16x8*>((const char*)Ks + KSWZ(32 + r32, cb));
    p0 = __builtin_amdgcn_mfma_f32_32x32x16_bf16(b0, qr[d0], p0, 0, 0, 0);
    p1 = __builtin_amdgcn_mfma_f32_32x32x16_bf16(b1, qr[d0], p1, 0, 0, 0); }
}
__device__ __forceinline__ int v_st(int k, int c) { const int kk = (k & ~0xC) | ((k & 4) << 1) | ((k & 8) >> 1); return ((kk >> 3) * 4 + (c >> 5)) * 512 + ((kk & 7) * 32 + (c & 31)) * 2; }
__device__ __forceinline__ int v_rd_base(int lane) { return ((lane & 3) << 3) | (((lane >> 2) & 3) << 6) | (((lane >> 4) & 1) << 5) | (((lane >> 5) & 1) << 8); }
constexpr int v_rd_off(int d0, int ks, int half) { return d0 * 512 + ks * 4096 + half * 2048; }
template <int OFF> __device__ __forceinline__ s16x4 tr_read(int vb) {
  s16x4 r; asm volatile("ds_read_b64_tr_b16 %0, %1 offset:%2" : "=&v"(r) : "v"(vb), "i"(OFF) : "memory"); return r;
}
template <int D0> __device__ __forceinline__ void pv_one(f32x16& od, int vb, bf16x8 pa0, bf16x8 pa1, bf16x8 pa2, bf16x8 pa3) {
  const s16x4 l0 = tr_read<v_rd_off(D0, 0, 0)>(vb), h0 = tr_read<v_rd_off(D0, 0, 1)>(vb), l1 = tr_read<v_rd_off(D0, 1, 0)>(vb), h1 = tr_read<v_rd_off(D0, 1, 1)>(vb);
  const s16x4 l2 = tr_read<v_rd_off(D0, 2, 0)>(vb), h2 = tr_read<v_rd_off(D0, 2, 1)>(vb), l3 = tr_read<v_rd_off(D0, 3, 0)>(vb), h3 = tr_read<v_rd_off(D0, 3, 1)>(vb);
  asm volatile("s_waitcnt lgkmcnt(0)" ::: "memory"); SBAR();
#define PK(L, H) (bf16x8){L[0], L[1], L[2], L[3], H[0], H[1], H[2], H[3]}
  od = __builtin_amdgcn_mfma_f32_32x32x16_bf16(pa0, PK(l0, h0), od, 0, 0, 0);
  od = __builtin_amdgcn_mfma_f32_32x32x16_bf16(pa1, PK(l1, h1), od, 0, 0, 0);
  od = __builtin_amdgcn_mfma_f32_32x32x16_bf16(pa2, PK(l2, h2), od, 0, 0, 0);
  od = __builtin_amdgcn_mfma_f32_32x32x16_bf16(pa3, PK(l3, h3), od, 0, 0, 0);
#undef PK
}
__device__ __forceinline__ void pv_d0(f32x16* o, int vb, bf16x8 pa0, bf16x8 pa1, bf16x8 pa2, bf16x8 pa3) {
  pv_one<0>(o[0], vb, pa0, pa1, pa2, pa3); pv_one<1>(o[1], vb, pa0, pa1, pa2, pa3); pv_one<2>(o[2], vb, pa0, pa1, pa2, pa3); pv_one<3>(o[3], vb, pa0, pa1, pa2, pa3);
}
__device__ __forceinline__ void attn_body(const bf16* __restrict__ Qb, int nq, const bf16* __restrict__ Kh, const bf16* __restrict__ Vh, int kvalid, int NT, float* __restrict__ Ob, char* lds) {
  int tid_ = threadIdx.x; asm volatile("" : "+v"(tid_));
  const int tid = tid_, wid = __builtin_amdgcn_readfirstlane(tid >> 6), lane = tid & 63, r32 = lane & 31, hi = lane >> 5;
  bf16* V_lds = (bf16*)lds; bf16* K_lds = (bf16*)(lds + 2 * SHM_V);
  float* ws = (float*)(lds + 2 * SHM_V + 2 * SHM_K) + wid * 64; float* li_l = ws; float* al_l = ws + 32;
  float m_reg = -1e30f, l_reg = 0; f32x16 o[4] = {}; bf16x8 qr[8];
  { const bf16* Qw = Qb + (long)(wid * QBLK + r32) * LDQ + hi * 8;
#pragma unroll
    for (int d0 = 0; d0 < 8; ++d0) qr[d0] = *reinterpret_cast<const bf16x8*>(Qw + d0 * 16); }
  const int sr = tid >> 4, sc = (tid & 15) * 8, vst0 = v_st(sr, sc), vst1 = v_st(32 + sr, sc);
  const int vb0 = (int)(uintptr_t)V_lds + v_rd_base(lane);
  struct { bf16x8 vs0, vs1, ks0, ks1; } sr_[2];
#define SLOAD(i, k0) do { sr_[i].vs0 = *reinterpret_cast<const bf16x8*>(&Vh[(long)((k0) + sr) * LDK + sc]); sr_[i].vs1 = *reinterpret_cast<const bf16x8*>(&Vh[(long)((k0) + 32 + sr) * LDK + sc]); \
    sr_[i].ks0 = *reinterpret_cast<const bf16x8*>(&Kh[(long)((k0) + sr) * LDK + sc]); sr_[i].ks1 = *reinterpret_cast<const bf16x8*>(&Kh[(long)((k0) + 32 + sr) * LDK + sc]); } while (0)
#define SWRITE(b, i) do { *(bf16x8*)((char*)V_lds + (b) * SHM_V + vst0) = sr_[i].vs0;          \
    *(bf16x8*)((char*)V_lds + (b) * SHM_V + vst1) = sr_[i].vs1; int kc = sc * 2;               \
    *(bf16x8*)((char*)K_lds + (b) * SHM_K + KSWZ(sr, kc)) = sr_[i].ks0;                       \
    *(bf16x8*)((char*)K_lds + (b) * SHM_K + KSWZ(32 + sr, kc)) = sr_[i].ks1; } while (0)
#define SWAIT() asm volatile("s_waitcnt vmcnt(4)" ::: "memory")
#define RESC(a) do { if (__any((a) < 1.f)) { if (hi == 0) al_l[r32] = (a); asm volatile("s_waitcnt lgkmcnt(0)" ::: "memory"); \
    _Pragma("unroll") for (int d = 0; d < 4; ++d) _Pragma("unroll") for (int r = 0; r < 16; ++r) o[d][r] *= al_l[crow(r, hi)]; } } while (0)
  f32x16 pA0, pA1, pB0, pB1; float mnA, mnB, alA, alB; bf16x8 pa0, pa1, pa2, pa3;
  constexpr int SE = 0, SO = 1;
  SLOAD(SE, 0); asm volatile("s_waitcnt vmcnt(0)" ::: "memory"); SWRITE(0, SE); __syncthreads();
  qkt(pA0, pA1, K_lds, qr, r32, hi); partialSM(pA0, pA1, m_reg, mnA, alA, kvalid, hi);
  SLOAD(SO, KVBLK); if (2 < NT) SLOAD(SE, 2 * KVBLK);
  SWAIT(); SWRITE(1, SO); __syncthreads();
  for (int j = 1; j + 1 < NT; j += 2) {
    SBAR(); qkt(pB0, pB1, (bf16*)((char*)K_lds + SHM_K), qr, r32, hi);
    finishSM(pA0, pA1, alA, l_reg, pa0, pa1, pa2, pa3); SBAR();
    SLOAD(SO, (j + 2) * KVBLK); SBAR();
    pv_d0(o, vb0, pa0, pa1, pa2, pa3); partialSM(pB0, pB1, m_reg, mnB, alB, kvalid - 64 * j, hi);
    __syncthreads(); SWAIT(); SWRITE(0, SE);
    RESC(alB); __syncthreads();
    SBAR(); qkt(pA0, pA1, K_lds, qr, r32, hi);
    finishSM(pB0, pB1, alB, l_reg, pa0, pa1, pa2, pa3); SBAR();
    if (j + 3 < NT) SLOAD(SE, (j + 3) * KVBLK); SBAR();
    pv_d0(o, vb0 + (int)SHM_V, pa0, pa1, pa2, pa3); partialSM(pA0, pA1, m_reg, mnA, alA, kvalid - 64 * (j + 1), hi);
    __syncthreads(); SWAIT(); SWRITE(1, SO);
    RESC(alA); __syncthreads();
  }
  SBAR(); qkt(pB0, pB1, (bf16*)((char*)K_lds + SHM_K), qr, r32, hi);
  finishSM(pA0, pA1, alA, l_reg, pa0, pa1, pa2, pa3); SBAR();
  pv_d0(o, vb0, pa0, pa1, pa2, pa3); partialSM(pB0, pB1, m_reg, mnB, alB, kvalid - 64 * (NT - 1), hi);
  __syncthreads(); RESC(alB);
  finishSM(pB0, pB1, alB, l_reg, pa0, pa1, pa2, pa3); SBAR();
  pv_d0(o, vb0 + (int)SHM_V, pa0, pa1, pa2, pa3);
  if (hi == 0) li_l[r32] = l_reg; asm volatile("s_waitcnt lgkmcnt(0)" ::: "memory");
  float rli[16];
#pragma unroll
  for (int r = 0; r < 16; ++r) rli[r] = __builtin_amdgcn_rcpf(li_l[crow(r, hi)]);
  float* Ow = Ob + (long)(wid * QBLK) * LDO;
#pragma unroll
  for (int r = 0; r < 16; ++r) { int orow = crow(r, hi);
    if (wid * QBLK + orow < nq) {
#pragma unroll
      for (int d0 = 0; d0 < 4; ++d0) Ow[(long)orow * LDO + d0 * 32 + r32] = o[d0][r] * rli[r]; } }
  __syncthreads();
#undef SLOAD
#undef SWRITE
#undef SWAIT
#undef RESC
}
}
namespace dat {
using namespace att;
__device__ __forceinline__ unsigned src_off(int p, int L) {
    const int reg = p >> 4, pp = p & 15; const int o = pp * 1024 + L * 16;
    if (reg < 2) { const int r = o >> 8, cc = (o >> 4) & 15; const int c = cc ^ (r & 7); return (unsigned)(r * LDK + reg * 128 + c * 8) * 2u; }
    const int st = o >> 9, w = o & 511; const int kk = ((st >> 2) << 3) | (w >> 6); const int c = ((st & 3) << 5) | ((w & 63) >> 1);
    const int k = (kk & ~0xC) | ((kk & 4) << 1) | ((kk & 8) >> 1);
    return (unsigned)(k * LDK + (reg - 2) * 128 + c) * 2u;
}
template <int D0> __device__ __forceinline__ void pv_one8(f32x16& od, int vb, bf16x8 pa0, bf16x8 pa1, bf16x8 pa2, bf16x8 pa3) {
  constexpr int HB = (D0 >> 2) * 16384, DD = D0 & 3;
  const s16x4 l0 = tr_read<HB + v_rd_off(DD, 0, 0)>(vb), h0 = tr_read<HB + v_rd_off(DD, 0, 1)>(vb), l1 = tr_read<HB + v_rd_off(DD, 1, 0)>(vb), h1 = tr_read<HB + v_rd_off(DD, 1, 1)>(vb);
  const s16x4 l2 = tr_read<HB + v_rd_off(DD, 2, 0)>(vb), h2 = tr_read<HB + v_rd_off(DD, 2, 1)>(vb), l3 = tr_read<HB + v_rd_off(DD, 3, 0)>(vb), h3 = tr_read<HB + v_rd_off(DD, 3, 1)>(vb);
  asm volatile("s_waitcnt lgkmcnt(0)" ::: "memory"); SBAR();
#define PK(L, H) (bf16x8){L[0], L[1], L[2], L[3], H[0], H[1], H[2], H[3]}
  od = __builtin_amdgcn_mfma_f32_32x32x16_bf16(pa0, PK(l0, h0), od, 0, 0, 0);
  od = __builtin_amdgcn_mfma_f32_32x32x16_bf16(pa1, PK(l1, h1), od, 0, 0, 0);
  od = __builtin_amdgcn_mfma_f32_32x32x16_bf16(pa2, PK(l2, h2), od, 0, 0, 0);
  od = __builtin_amdgcn_mfma_f32_32x32x16_bf16(pa3, PK(l3, h3), od, 0, 0, 0);
#undef PK
}
__device__ __forceinline__ void dattn_unit(const bf16* __restrict__ Qb, const bf16* __restrict__ Kh, const bf16* __restrict__ Vh, int nq, int kv_lo, int kv_hi, int NT,
                                           bf16* __restrict__ outp, const float* __restrict__ gnorm, float lam, unsigned char* lds, int tid_in) {
  const int tid_ = tid_in;
  const int tid = tid_, wid = __builtin_amdgcn_readfirstlane(tid >> 6), lane = tid & 63, r32 = lane & 31, hi = lane >> 5;
  const int br = wid >> 2, rg = wid & 3;
  const bool active = rg * 32 < nq;
  const int kvalid = rg < 2 ? kv_lo : kv_hi;
  float* wsf = (float*)(lds + 131072) + wid * 64; float* li_l = wsf; float* al_l = wsf + 32;
  float m_reg = -1e30f, l_reg = 0; f32x16 o[8];
#pragma unroll
  for (int d = 0; d < 8; ++d) o[d] = f32x16{};
  bf16x8 qr[8];
  { const bf16* Qw = Qb + (long)(rg * 32 + r32) * 2048 + br * 128 + hi * 8;
#pragma unroll
    for (int d0 = 0; d0 < 8; ++d0) qr[d0] = *reinterpret_cast<const bf16x8*>(Qw + d0 * 16); }
#define DMA_TILE(t, buf) do { const char* kt = (const char*)Kh + (size_t)(t) * (64 * 2048 * 2); const char* vt = (const char*)Vh + (size_t)(t) * (64 * 2048 * 2); \
    _Pragma("unroll") for (int i = 0; i < 8; ++i) __builtin_amdgcn_global_load_lds((const unsigned*)((wid < 4 ? kt : vt) + src_off(wid * 8 + i, lane)), (LAS unsigned*)(lds + (buf) * 65536 + (wid * 8 + i) * 1024), 16, 0, 0); } while (0)
  DMA_TILE(0, 0);
  for (int t = 0; t < NT; ++t) {
    asm volatile("s_waitcnt vmcnt(0)" ::: "memory");
    __builtin_amdgcn_s_barrier();
    if (t + 1 < NT) DMA_TILE(t + 1, (t + 1) & 1);
    const int rem = kvalid - 64 * t;
    if (active && rem > 0) {
      const bf16* Ks = (const bf16*)(lds + (t & 1) * 65536 + br * 16384);
      const int vb = (int)(uintptr_t)(lds + (t & 1) * 65536 + 32768) + v_rd_base(lane);
      f32x16 p0, p1; float mn, al; bf16x8 pa0, pa1, pa2, pa3;
      p0 = f32x16{}; p1 = f32x16{};
#pragma unroll
      for (int d0 = 0; d0 < 8; ++d0) { const int cb = (d0 * 16 + hi * 8) * 2;
        const bf16x8 b0 = *reinterpret_cast<const bf16x8*>((const char*)Ks + KSWZ(r32, cb));
        const bf16x8 b1 = *reinterpret_cast<const bf16x8*>((const char*)Ks + KSWZ(32 + r32, cb));
        p0 = __builtin_amdgcn_mfma_f32_32x32x16_bf16(b0, qr[d0], p0, 0, 0, 0);
        p1 = __builtin_amdgcn_mfma_f32_32x32x16_bf16(b1, qr[d0], p1, 0, 0, 0);
        }
      partialSM(p0, p1, m_reg, mn, al, rem, hi);
      if (__any(al < 1.f)) { if (hi == 0) al_l[r32] = al; asm volatile("s_waitcnt lgkmcnt(0)" ::: "memory");
#pragma unroll
        for (int d = 0; d < 8; ++d)
#pragma unroll
          for (int r = 0; r < 16; ++r) o[d][r] *= al_l[crow(r, hi)]; }
      finishSM(p0, p1, al, l_reg, pa0, pa1, pa2, pa3); SBAR();
      pv_one8<0>(o[0], vb, pa0, pa1, pa2, pa3); pv_one8<1>(o[1], vb, pa0, pa1, pa2, pa3); pv_one8<2>(o[2], vb, pa0, pa1, pa2, pa3); pv_one8<3>(o[3], vb, pa0, pa1, pa2, pa3);
      pv_one8<4>(o[4], vb, pa0, pa1, pa2, pa3); pv_one8<5>(o[5], vb, pa0, pa1, pa2, pa3); pv_one8<6>(o[6], vb, pa0, pa1, pa2, pa3); pv_one8<7>(o[7], vb, pa0, pa1, pa2, pa3);
    }
  }
#undef DMA_TILE
  if (hi == 0) li_l[r32] = l_reg; asm volatile("s_waitcnt lgkmcnt(0)" ::: "memory");
  float rli[16];
#pragma unroll
  for (int r = 0; r < 16; ++r) rli[r] = __builtin_amdgcn_rcpf(li_l[crow(r, hi)]);
  __builtin_amdgcn_s_barrier();
  float* ex = (float*)lds + (size_t)rg * 8192;
  if (br == 1) {
#pragma unroll
    for (int d = 0; d < 8; ++d)
#pragma unroll
      for (int r = 0; r < 16; ++r) ex[(d * 16 + r) * 64 + lane] = o[d][r] * rli[r] * lam;
  }
  asm volatile("s_waitcnt lgkmcnt(0)" ::: "memory"); __builtin_amdgcn_s_barrier(); asm volatile("" ::: "memory");
  if (br == 0 && active) {
    float ss[16];
#pragma unroll
    for (int r = 0; r < 16; ++r) ss[r] = 0.f;
#pragma unroll
    for (int d = 0; d < 8; ++d)
#pragma unroll
      for (int r = 0; r < 16; ++r) { const float v = o[d][r] * rli[r] - ex[(d * 16 + r) * 64 + lane]; o[d][r] = v; ss[r] = fmaf(v, v, ss[r]); }
#pragma unroll
    for (int r = 0; r < 16; ++r) { float v = ss[r]; v += xor1(v); v += xor2(v); v += xor4s(v); v += xor8(v); v += xor16(v);
        ss[r] = rsqrtf(v * (1.f / 256.f) + LN_EPS) * (1.f - LAM_INIT); }
#pragma unroll
    for (int d = 0; d < 8; ++d) { const float g = gnorm[32 * d + r32];
#pragma unroll
      for (int r = 0; r < 16; ++r) { const int rk = rg * 32 + (r & 3) + 8 * (r >> 2);
          if (rk + 4 * hi < nq) *(unsigned short*)((unsigned char*)outp + (size_t)rk * 8192 + 64 * d + (unsigned)(hi * (4 * 8192) + r32 * 2)) = (unsigned short)f2bf(o[d][r] * ss[r] * g); } }
  }
  asm volatile("s_waitcnt lgkmcnt(0)" ::: "memory"); __builtin_amdgcn_s_barrier(); asm volatile("" ::: "memory");
}
}
__device__ __forceinline__ unsigned cvt2(float lo, float hi) { const f32x2 v = {lo, hi}; return __builtin_bit_cast(unsigned, __builtin_convertvector(v, bf16x2_t)); }
__device__ __forceinline__ bf16x8 pack_acc(const f32x16& x, int s) {
    v4u p; p.x = cvt2(x[8 * s + 0], x[8 * s + 1]); p.y = cvt2(x[8 * s + 2], x[8 * s + 3]); p.z = cvt2(x[8 * s + 4], x[8 * s + 5]); p.w = cvt2(x[8 * s + 6], x[8 * s + 7]);
    return __builtin_bit_cast(bf16x8, p);
}
__device__ __forceinline__ void gla_scan_unit(Frame& F, int unit) {
    const int half = unit & 1, h = (unit >> 1) & 3, b = unit >> 3;
    int t_ = F.wave * 64 + lane_id_v();
    const int t = t_, lane = t & 63, r32 = t & 31, hi = (t >> 5) & 1; const int wave = F.wave;
    constexpr int STG = 74752;
    const int dvc = 256 * half + 32 * wave + r32;
    bf16* MIXIN = (bf16*)(F.ws + WS_F);
    f32x16 S[8];
#pragma unroll
    for (int i = 0; i < 8; ++i) S[i] = f32x16{};
    const int item0 = (b * 4 + h) * 128;
    const char* QINg = (const char*)(F.ws + WS_QIN) + (size_t)item0 * 32768; const char* KEg = (const char*)(F.ws + WS_KENDT) + (size_t)item0 * 32768;
    const char* AMg = (const char*)(F.ws + WS_AM) + (size_t)item0 * 8192; const char* DECg = (const char*)(F.ws + WS_DEC) + (size_t)item0 * 1024;
    const bf16* VTg = (const bf16*)(F.ws + WS_E) + (size_t)item0 * 512 * 64 + (size_t)dvc * 64 + 8 * hi;
#define SCAN_DMA(c, buf) do { for (int p = wave; p < 73; p += 8) { \
        const char* src = p < 32 ? QINg + (size_t)(c) * 32768 + p * 1024 : p < 64 ? KEg + (size_t)(c) * 32768 + (p - 32) * 1024 : p < 72 ? AMg + (size_t)(c) * 8192 + (p - 64) * 1024 : DECg + (size_t)(c) * 1024; \
        __builtin_amdgcn_global_load_lds((const unsigned*)(src + lane * 16), (LAS unsigned*)(F.lds + (buf) * STG + p * 1024), 16, 0, 0); } } while (0)
    __syncthreads();
    SCAN_DMA(0, 0);
    bf16x8 vt[4];
#pragma unroll
    for (int ks = 0; ks < 4; ++ks) vt[ks] = *(const bf16x8*)(VTg + 16 * ks);
    for (int c = 0; c < 128; ++c) {
        asm volatile("s_waitcnt vmcnt(0)" ::: "memory");
        __builtin_amdgcn_s_barrier(); asm volatile("" ::: "memory");
        bf16x8 vn[4];
#pragma unroll
        for (int ks = 0; ks < 4; ++ks) vn[ks] = vt[ks];
        if (c + 1 < 128) SCAN_DMA(c + 1, (c + 1) & 1);
        const unsigned char* sb = F.lds + (c & 1) * STG;
        const unsigned char* qsm = sb; const unsigned char* ksm = sb + 32768; const unsigned char* asm_ = sb + 65536; const float* dsm = (const float*)(sb + 73728);
        f32x16 o0 = f32x16{}, o1 = f32x16{};
#pragma unroll
        for (int dkt = 0; dkt < 8; ++dkt) {
#pragma unroll
            for (int s = 0; s < 2; ++s) {
                const bf16x8 xs = pack_acc(S[dkt], s);
                const int ch = 2 * (2 * dkt + s) + hi;
                const bf16x8 a0 = *(const bf16x8*)(qsm + r32 * 512 + ((ch ^ r32) << 4)), a1 = *(const bf16x8*)(qsm + (32 + r32) * 512 + ((ch ^ r32) << 4));
                o0 = MFMA32(a0, xs, o0); o1 = MFMA32(a1, xs, o1);
            }
            __builtin_amdgcn_sched_barrier(0);
        }
#pragma unroll
        for (int ks = 0; ks < 4; ++ks) { const int sw = ((2 * ks + hi) ^ ((r32 >> 1) & 7)) << 4;
            const bf16x8 a0 = *(const bf16x8*)(asm_ + r32 * 128 + sw), a1 = *(const bf16x8*)(asm_ + (32 + r32) * 128 + sw);
            o0 = MFMA32(a0, vt[ks], o0); o1 = MFMA32(a1, vt[ks], o1);
        }
        { unsigned char* rowbase = (unsigned char*)MIXIN + (((size_t)b * SEQ + 64 * c) * 4096 + 2048 + h * 512 + 256 * half + 32 * wave) * 2;
          const unsigned lane_off = (unsigned)(hi * (4 * 8192) + r32 * 2);
#pragma unroll
          for (int r = 0; r < 16; ++r) { const int rk = (r & 3) + 8 * (r >> 2);
              *(unsigned short*)(rowbase + (size_t)rk * 8192 + lane_off) = (unsigned short)f2bf(o0[r]); *(unsigned short*)(rowbase + (size_t)(rk + 32) * 8192 + lane_off) = (unsigned short)f2bf(o1[r]); } }
        if (c + 1 < 128) {
#pragma unroll
            for (int ks = 0; ks < 4; ++ks) vn[ks] = *(const bf16x8*)(VTg + (size_t)(c + 1) * 512 * 64 + 16 * ks); }
#pragma unroll
        for (int dkt = 0; dkt < 8; ++dkt) {
#pragma unroll
            for (int g4 = 0; g4 < 4; ++g4) { const f32x4 dv4 = *(const f32x4*)(dsm + 32 * dkt + 8 * g4 + 4 * hi);
#pragma unroll
                for (int e = 0; e < 4; ++e) S[dkt][4 * g4 + e] *= dv4[e]; }
#pragma unroll
            for (int ks = 0; ks < 4; ++ks) { const bf16x8 a = *(const bf16x8*)(ksm + (32 * dkt + r32) * 128 + (((2 * ks + hi) ^ ((r32 >> 1) & 7)) << 4)); S[dkt] = MFMA32(a, vt[ks], S[dkt]); }
            __builtin_amdgcn_sched_barrier(0);
        }
#pragma unroll
        for (int ks = 0; ks < 4; ++ks) vt[ks] = vn[ks];
    }
#undef SCAN_DMA
    float* SO = F.out + O_GP + ((size_t)(b * 4 + h) * 256) * 512 + dvc;
#pragma unroll
    for (int dkt = 0; dkt < 8; ++dkt)
#pragma unroll
        for (int r = 0; r < 16; ++r) SO[(size_t)(32 * dkt + crow(r, hi)) * 512] = S[dkt][r];
    asm volatile("s_waitcnt vmcnt(0) lgkmcnt(0)" ::: "memory"); __syncthreads();
}
__device__ __forceinline__ void cvt_tables_unit(Frame& F, int unit) {
    unsigned char* UQ = F.ws + WS_G; unsigned char* VQ = F.ws + WS_G + 64 * MiB;
    const size_t i0 = (size_t)unit * (32 * DM / 16);
    for (int k = (F.wave * 64 + lane_id_v()); k < 32 * DM / 16; k += 512) { const size_t i = i0 + k;
#pragma unroll
        for (int tb = 0; tb < 2; ++tb) { const float* src = (tb ? F.peer_v : F.peer_u) + i * 16; const float sc = tb ? 4.f : 64.f; v4u o;
#pragma unroll
            for (int w = 0; w < 4; ++w) { const f32x4 a = *(const f32x4*)(src + 4 * w); int pk = __builtin_amdgcn_cvt_pk_fp8_f32(a[0] * sc, a[1] * sc, 0, false); pk = __builtin_amdgcn_cvt_pk_fp8_f32(a[2] * sc, a[3] * sc, pk, true); o[w] = (unsigned)pk; }
            *(v4u*)((tb ? VQ : UQ) + i * 16) = o; } }
}
__device__ __forceinline__ void cvt_tables_drain(Frame& F, int max_units) {
    volatile unsigned* slot = (volatile unsigned*)(F.lds + MISC_OFF + 64);
    for (int n = 0; n < max_units; ++n) {
        __syncthreads();
        if ((F.wave * 64 + lane_id_v()) == 0) *slot = __hip_atomic_fetch_add((unsigned*)(F.ctl + CW_QUEUE + 64 * 8), 1u, __ATOMIC_RELAXED, __HIP_MEMORY_SCOPE_AGENT);
        __syncthreads();
        const int u = __builtin_amdgcn_readfirstlane((int)*slot);
        if (u >= 512) break;
        cvt_tables_unit(F, u);
    }
}
__device__ __forceinline__ void p3_attn_scan(Frame& F) {
    volatile unsigned* slot = (volatile unsigned*)(F.lds + MISC_OFF + 64);
    const bf16* QB = (const bf16*)(F.ws + WS_C); const bf16* KB = (const bf16*)(F.ws + WS_C + SZ_TOK2048); const bf16* VB = (const bf16*)(F.ws + WS_C + 2 * SZ_TOK2048);
    const bf16* KSB = (const bf16*)(F.ws + WS_H); const bf16* VSB = (const bf16*)(F.ws + WS_H + 72 * MiB);
    bf16* MIXIN = (bf16*)(F.ws + WS_F);
    float lam;
    { const int lane = lane_id_v(); const float s1 = wave_sum(F.lq1[lane] * F.lk1[lane] + F.lq1[lane + 64] * F.lk1[lane + 64]);
      const float s2 = wave_sum(F.lq2[lane] * F.lk2[lane] + F.lq2[lane + 64] * F.lk2[lane + 64]);
      lam = expf(s1) - expf(s2) + LAM_INIT; }
    constexpr int QN = 2 + 8 + 128 + 16;
    const int q0 = (int)(xb_xcc_id() & 7u);
    for (int dq = 0; dq < 8; ++dq) {
      const int q = (q0 + dq) & 7;
      for (;;) {
        __syncthreads();
        if ((F.wave * 64 + lane_id_v()) == 0) *slot = __hip_atomic_fetch_add((unsigned*)(F.ctl + CW_QUEUE + 64 * q), 1u, __ATOMIC_RELAXED, __HIP_MEMORY_SCOPE_AGENT);
        __syncthreads();
        const int u = __builtin_amdgcn_readfirstlane((int)*slot);
        if (u >= QN) break;
#ifndef NREP_S
#define NREP_S 1
#endif
        if (u < 2) { for (int rr = 0; rr < NREP_S; ++rr) gla_scan_unit(F, 2 * q + u); continue; }
        if (u < 10) { gla_sample_item(F, 8 * q + (u - 2)); continue; }
        int v = u - 10;
        const bf16 *Qp, *Kp, *Vp; bf16* Op; int nq, kv_lo, kv_hi, NT;
        if (v < 128) {
            const int a = v, jb = 63 - (a >> 1), pr = 2 * q + (a & 1), h = pr & 7, b = pr >> 3;
            const size_t row0 = (size_t)b * SEQ;
            Kp = KB + row0 * 2048 + h * 256; Vp = VB + row0 * 2048 + h * 256; Qp = QB + (row0 + 128 * jb) * 2048 + h * 256;
            Op = MIXIN + (row0 + 128 * jb) * 4096 + h * 256; nq = 128; kv_lo = 64 * (2 * jb + 1); kv_hi = 64 * (2 * jb + 2); NT = 2 * jb + 2;
        } else {
            v -= 128; const int h = v & 7, sb = 2 * q + (v >> 3);
            const size_t rowq = (size_t)TP + sb * 16;
            Kp = KSB + (size_t)sb * 1152 * 2048 + h * 256; Vp = VSB + (size_t)sb * 1152 * 2048 + h * 256; Qp = QB + rowq * 2048 + h * 256;
            Op = MIXIN + rowq * 4096 + h * 256; nq = 16; kv_lo = 1040; kv_hi = 1040; NT = 17;
        }
#ifndef NREP_A
#define NREP_A 1
#endif
        for (int rr = 0; rr < NREP_A; ++rr) dat::dattn_unit(Qp, Kp, Vp, nq, kv_lo, kv_hi, NT, Op, F.dng, lam, F.lds, F.wave * 64 + lane_id_v());
      }
    }
}
__device__ __forceinline__ void p3b_finalize(Frame& F, bool dummy) {
    const int gw = F.bid * NWAVES + F.wave, NGW = F.G * NWAVES, lane = lane_id_v();
    bf16* MIXIN = (bf16*)(F.ws + WS_F); const bf16* GR = (const bf16*)(F.ws + WS_D + 2 * SZ_TOK2048);
    const f32x4 g0 = *(const f32x4*)(F.gng + 8 * lane), g1 = *(const f32x4*)(F.gng + 8 * lane + 4);
    for (int m = gw; m < MTOK; m += NGW) {
        v4u raw[4], gr[4];
#pragma unroll
        for (int h = 0; h < 4; ++h) { raw[h] = *(const v4u*)(MIXIN + (size_t)m * 4096 + 2048 + h * 512 + 8 * lane); gr[h] = *(const v4u*)(GR + (size_t)m * 2048 + h * 512 + 8 * lane); }
#pragma unroll
        for (int h = 0; h < 4; ++h) {
            const float x[8] = {bflo(raw[h].x), bfhi(raw[h].x), bflo(raw[h].y), bfhi(raw[h].y), bflo(raw[h].z), bfhi(raw[h].z), bflo(raw[h].w), bfhi(raw[h].w)};
            const float gg[8] = {bflo(gr[h].x), bfhi(gr[h].x), bflo(gr[h].y), bfhi(gr[h].y), bflo(gr[h].z), bfhi(gr[h].z), bflo(gr[h].w), bfhi(gr[h].w)};
            float ss = 0.f;
#pragma unroll
            for (int e = 0; e < 8; ++e) ss += x[e] * x[e];
            ss = wave_sum(ss); const float rs = rsqrtf(ss * (1.f / 512.f) + LN_EPS);
            float y[8];
#pragma unroll
            for (int e = 0; e < 8; ++e) { const float gn = e < 4 ? g0[e & 3] : g1[e & 3]; const float sl = gg[e] / (1.f + __expf(-gg[e])); y[e] = x[e] * rs * gn * sl; }
            bf16* p = (dummy ? (bf16*)(F.ws + WS_C) : MIXIN) + (size_t)m * 4096 + 2048 + h * 512 + 8 * lane;
            *(v4u*)p = (v4u){pk2(y[0], y[1]), pk2(y[2], y[3]), pk2(y[4], y[5]), pk2(y[6], y[7])};
        }
    }
}
__device__ __forceinline__ void p5_ln1(Frame& F, bool dummy) {
    const int gw = F.bid * NWAVES + F.wave, NGW = F.G * NWAVES, lane = lane_id_v();
    float* Y = F.out + O_Y; bf16* X1B = (bf16*)(F.ws + WS_A);
    for (int m = gw; m < MTOK; m += NGW) {
        float* yr = Y + (size_t)m * DM; f32x4 v[16]; float s = 0.f;
#pragma unroll
        for (int j = 0; j < 16; ++j) { v[j] = *(const f32x4*)(yr + 4 * (lane + 64 * j)); s += (v[j][0] + v[j][1]) + (v[j][2] + v[j][3]); }
        const float mean = wave_sum(s) * (1.f / DM); float s2 = 0.f;
#pragma unroll
        for (int j = 0; j < 16; ++j) { v[j] = v[j] - mean; s2 += (v[j][0] * v[j][0] + v[j][1] * v[j][1]) + (v[j][2] * v[j][2] + v[j][3] * v[j][3]); }
        const float rstd = rsqrtf(wave_sum(s2) * (1.f / DM) + LN_EPS);
#pragma unroll
        for (int j = 0; j < 16; ++j) { const int c = 4 * (lane + 64 * j); const f32x4 g = *(const f32x4*)(F.ln1g + c), bb = *(const f32x4*)(F.ln1b + c);
            const f32x4 o = v[j] * rstd * g + bb; *(f32x4*)((dummy ? (float*)(F.ws + WS_C) + (size_t)m * DM : yr) + c) = o;
            v2u w; w.x = pk2(o[0], o[1]); w.y = pk2(o[2], o[3]); *(v2u*)((dummy ? (bf16*)(F.ws + WS_E) : X1B) + (size_t)(dummy ? (m & 4095) : m) * DM + c) = w; }
    }
}
__device__ __forceinline__ int mono(float f) { const int u = __builtin_bit_cast(int, f); return u ^ ((u >> 31) & 0x7fffffff); }
__device__ __forceinline__ float unmono(int s) { return __builtin_bit_cast(float, s ^ ((s >> 31) & 0x7fffffff)); }
#define CE_DESC(A, i_, j_) do { const int a_ = A[i_], b_ = A[j_]; A[i_] = max(a_, b_); A[j_] = min(a_, b_); } while (0)
__device__ __forceinline__ void sort16_desc(int (&A)[16]) {
#pragma unroll
    for (int k = 2; k <= 16; k <<= 1)
#pragma unroll
        for (int j = k >> 1; j > 0; j >>= 1)
#pragma unroll
            for (int i = 0; i < 16; ++i) { const int l = i ^ j; if (l > i) { if ((i & k) == 0) CE_DESC(A, i, l); else CE_DESC(A, l, i); } }
}
__device__ __forceinline__ void merge16_desc(int (&A)[16], const int (&B)[16]) {
#pragma unroll
    for (int q = 0; q < 16; ++q) A[q] = max(A[q], B[15 - q]);
#pragma unroll
    for (int dd = 8; dd >= 1; dd >>= 1)
#pragma unroll
        for (int q = 0; q < 16; ++q) if ((q & dd) == 0) CE_DESC(A, q, q + dd);
}
__device__ __forceinline__ void top16_of_128(const f32x16 (&sc)[4], int hi, int (&L)[16]) {
    int G[16];
#pragma unroll
    for (int kt = 0; kt < 4; ++kt) {
#pragma unroll
        for (int r = 0; r < 16; ++r) { const int key = 32 * kt + (r & 3) + 8 * (r >> 2) + 4 * hi; G[r] = (mono(sc[kt][r]) & ~127) | key; }
        sort16_desc(G);
        if (kt == 0) {
#pragma unroll
            for (int q = 0; q < 16; ++q) L[q] = G[q];
        } else merge16_desc(L, G);
        __builtin_amdgcn_sched_barrier(0);
    }
#pragma unroll
    for (int q = 0; q < 16; ++q) { const auto rr = __builtin_amdgcn_permlane32_swap((unsigned)L[q], (unsigned)L[q], false, false); G[q] = (int)(hi ? rr[0] : rr[1]); }
    merge16_desc(L, G);
}
__device__ __forceinline__ void p7_peer_select(Frame& F) {
    int t_ = F.wave * 64 + lane_id_v();
    const int tid = t_, lane = t_ & 63, r32 = lane & 31, hi = lane >> 5, wave = F.wave;
    const bf16* QP = (const bf16*)(F.ws + WS_B); const bf16* KEYB = (const bf16*)(F.ws + WS_KEYB);
    int* IDX = (int*)(F.ws + WS_IDX); float* GATE = (float*)(F.ws + WS_GATE);
    const int h = F.bid & 7, g = F.bid >> 3;
    unsigned char* ks = F.lds;
    __syncthreads();
    for (int k = tid; k < 2 * 128 * 16; k += 512) { const int half = k >> 11, key = (k >> 4) & 127, pc = k & 15;
        *(v4u*)(ks + (half * 128 + key) * 272 + 16 * pc) = *(const v4u*)(KEYB + ((size_t)(half * 8 + h) * 128 + key) * 128 + 8 * pc); }
    __syncthreads();
    for (int kk = wave; g + 32 * kk < MTOK / 32; kk += 8) {
        const int tt = g + 32 * kk; const int tok = 32 * tt + r32;
        int T1[16], T2[16];
#pragma unroll
        for (int half = 0; half < 2; ++half) {
            f32x16 sc[4];
#pragma unroll
            for (int kt = 0; kt < 4; ++kt) sc[kt] = f32x16{};
            const char* qb = (const char*)(QP + (size_t)(32 * tt) * 2048 + h * 256 + half * 128);
            unsigned qoff = (unsigned)(r32 * 4096 + hi * 16); asm volatile("" : "+v"(qoff));
            bf16x8 bq[8];
#pragma unroll
            for (int s = 0; s < 8; ++s) bq[s] = *(const bf16x8*)(qb + 32 * s + qoff);
            const unsigned char* kb = ks + half * (128 * 272) + r32 * 272 + hi * 16;
#pragma unroll
            for (int s = 0; s < 8; ++s) {
#pragma unroll
                for (int kt = 0; kt < 4; ++kt) { const bf16x8 a = *(const bf16x8*)(kb + kt * (32 * 272) + 32 * s); sc[kt] = MFMA32(a, bq[s], sc[kt]); }
                if (s & 1) __builtin_amdgcn_sched_barrier(0); }
            if (half == 0) top16_of_128(sc, hi, T1); else top16_of_128(sc, hi, T2);
            __builtin_amdgcn_sched_barrier(0);
        }
        int C[16], Gc[16];
#pragma unroll
        for (int grp = 0; grp < 4; ++grp) {
#pragma unroll
            for (int q = 0; q < 16; ++q) Gc[q] = (int)0x80000000;
            { int n = 0, slot = 0;
#pragma unroll
              for (int a = 0; a < 16; ++a)
#pragma unroll
                  for (int bq = 0; bq < 16; ++bq) if ((a + 1) * (bq + 1) <= 16) { if (n / 16 == grp) { Gc[slot] = (mono(unmono(T1[a] & ~127) + unmono(T2[bq] & ~127)) & ~255) | (a * 16 + bq); ++slot; } ++n; } }
            sort16_desc(Gc);
            if (grp == 0) {
#pragma unroll
                for (int q = 0; q < 16; ++q) C[q] = Gc[q];
            } else merge16_desc(C, Gc);
            __builtin_amdgcn_sched_barrier(0);
        }
        float best[16]; int eidx[16]; float den = 0.f;
#pragma unroll
        for (int q = 0; q < 16; ++q) {
            const int code = C[q] & 255, ca = code >> 4, cb = code & 15; int i1 = 0, i2 = 0;
#pragma unroll
            for (int a = 0; a < 16; ++a) { i1 = (ca == a) ? (T1[a] & 127) : i1; i2 = (cb == a) ? (T2[a] & 127) : i2; }
            eidx[q] = i1 * 128 + i2;
            best[q] = __expf(unmono(C[q] & ~255) - unmono(C[0] & ~255)); den += best[q];
        }
        const float rden = 1.f / den;
        if (hi == 0) {
            int* ip = IDX + (size_t)tok * 128 + h * 16; float* gp = GATE + (size_t)tok * 128 + h * 16;
#pragma unroll
            for (int q = 0; q < 16; q += 4) { *(int4*)(ip + q) = make_int4(eidx[q], eidx[q + 1], eidx[q + 2], eidx[q + 3]); *(f32x4*)(gp + q) = (f32x4){best[q] * rden, best[q + 1] * rden, best[q + 2] * rden, best[q + 3] * rden}; }
        }
    }
}
__device__ __forceinline__ float dot2bf(unsigned w, unsigned x, float acc) { return __builtin_amdgcn_fdot2_f32_bf16(__builtin_bit_cast(bf16x2_t, w), __builtin_bit_cast(bf16x2_t, x), acc, false); }
__device__ __forceinline__ float gelu_erf(float x) { return 0.5f * x * (1.f + erff(x * 0.70710678118654752f)); }
typedef _Float16 h16x2 __attribute__((ext_vector_type(2)));
__device__ __forceinline__ void p8_peer_gather(Frame& F) {
    int t_ = F.wave * 64 + lane_id_v();
    const int tid = t_, lane = tid & 63, wave = F.wave, sub = lane & 7, pg = lane >> 3;
    unsigned* idx_s = (unsigned*)F.lds;
    float* cf_s = (float*)(F.lds + 33280);
    float* part_s = (float*)(F.lds + 2 * 33280);
    bf16* xs_w = (bf16*)(F.lds + 2 * 33280 + 4096) + wave * (9 * 128);
    const bf16* X1B = (const bf16*)(F.ws + WS_A); const char* UQ = (const char*)(F.ws + WS_G); const char* VQ = (const char*)(F.ws + WS_G + 64 * MiB);
    const int* IDX = (const int*)(F.ws + WS_IDX); const float* GATE = (const float*)(F.ws + WS_GATE);
    float* Y = F.out + O_Y;
    __syncthreads();
    for (int k = tid; k < 65 * 128; k += 512) { const int j = k >> 7, p = k & 127; const size_t m = (size_t)F.bid + 256 * j; const int pos = j * 128 + (p & 7) * 16 + (p >> 3);
        idx_s[pos] = (unsigned)IDX[m * 128 + p] * 4096u; cf_s[pos] = GATE[m * 128 + p]; }
    __syncthreads();
    float acc[9][16];
#pragma unroll
    for (int q = 0; q < 9; ++q)
#pragma unroll
        for (int i = 0; i < 16; ++i) acc[q][i] = 0.f;
#ifndef NREP_U
#define NREP_U 1
#endif
#ifndef NREP_V
#define NREP_V 1
#endif
    for (int s_ = 0; s_ < 32 * NREP_U; ++s_) { const int s = s_ & 31;
        if (NREP_U > 1 && s_ == 32) {
#pragma unroll
            for (int q = 0; q < 9; ++q)
#pragma unroll
                for (int i = 0; i < 16; ++i) acc[q][i] = 0.f;
        }
        { const int tsl = lane >> 4, pc = lane & 15;
#pragma unroll
          for (int r = 0; r < 3; ++r) { const int q = 4 * r + tsl; if (q < 9) { const int j = q < 8 ? wave + 8 * q : 64;
              *(v4u*)(xs_w + q * 128 + 8 * pc) = *(const v4u*)(X1B + ((size_t)F.bid + 256 * j) * DM + 128 * s + 8 * pc); } }
          asm volatile("s_waitcnt vmcnt(0) lgkmcnt(0)" ::: "memory"); }
        const char* ub = UQ + s * 128 + sub * 16;
#pragma unroll
        for (int q = 0; q < 9; ++q) { const int j = q < 8 ? wave + 8 * q : 64;
            if (q < 8 ? (wave + 8 * q < 65) : ((s & 7) == wave)) {
                const v4u xr0 = *(const v4u*)(xs_w + q * 128 + 16 * sub), xr1 = *(const v4u*)(xs_w + q * 128 + 16 * sub + 8);
                const unsigned xw[8] = {xr0.x, xr0.y, xr0.z, xr0.w, xr1.x, xr1.y, xr1.z, xr1.w};
#pragma unroll
                for (int hb = 0; hb < 2; ++hb) {
                    const v4u i0 = *(const v4u*)(idx_s + j * 128 + pg * 16 + 8 * hb), i1 = *(const v4u*)(idx_s + j * 128 + pg * 16 + 8 * hb + 4);
                    const unsigned iw[8] = {i0.x, i0.y, i0.z, i0.w, i1.x, i1.y, i1.z, i1.w};
                    v4u d[8];
#pragma unroll
                    for (int i = 0; i < 8; ++i) d[i] = *(const v4u*)(ub + iw[i]);
#pragma unroll
                    for (int i = 0; i < 8; ++i) { float a = acc[q][8 * hb + i];
#pragma unroll
                        for (int w = 0; w < 4; ++w) {
                            a = __builtin_amdgcn_fdot2_f32_bf16(__builtin_amdgcn_cvt_scalef32_pk_bf16_fp8(d[i][w], 1.0f, false), __builtin_bit_cast(bf16x2_t, xw[2 * w]), a, false);
                            a = __builtin_amdgcn_fdot2_f32_bf16(__builtin_amdgcn_cvt_scalef32_pk_bf16_fp8(d[i][w], 1.0f, true), __builtin_bit_cast(bf16x2_t, xw[2 * w + 1]), a, false); }
                        acc[q][8 * hb + i] = a; }
                }
            }
        }
    }
#pragma unroll
    for (int q = 0; q < 9; ++q) { const int j = q < 8 ? wave + 8 * q : 64;
#pragma unroll
        for (int i = 0; i < 16; ++i) { float v = acc[q][i]; v += xor1(v); v += xor2(v); v += xor4s(v);
            if (sub == 0) { if (q < 8) { const int pos = j * 128 + pg * 16 + i; cf_s[pos] = cf_s[pos] * gelu_erf(v * 0.015625f) * 0.25f; } else part_s[wave * 128 + pg * 16 + i] = v; } } }
    __syncthreads();
    if (tid < 128) { float v = 0.f;
#pragma unroll
        for (int w = 0; w < 8; ++w) v += part_s[w * 128 + tid];
        cf_s[64 * 128 + tid] = cf_s[64 * 128 + tid] * gelu_erf(v * 0.015625f) * 0.25f; }
    __syncthreads();
#define VLOAD(D, jj, hb) do { const v4u i0_ = *(const v4u*)(idx_s + (jj) * 128 + pg * 16 + 8 * (hb)), i1_ = *(const v4u*)(idx_s + (jj) * 128 + pg * 16 + 8 * (hb) + 4); \
        D[0] = *(const v4u*)(vb + i0_.x); D[1] = *(const v4u*)(vb + i0_.y); D[2] = *(const v4u*)(vb + i0_.z); D[3] = *(const v4u*)(vb + i0_.w); \
        D[4] = *(const v4u*)(vb + i1_.x); D[5] = *(const v4u*)(vb + i1_.y); D[6] = *(const v4u*)(vb + i1_.z); D[7] = *(const v4u*)(vb + i1_.w); } while (0)
#define VCOMP(D, C0, C1) do { _Pragma("unroll") for (int i = 0; i < 8; ++i) { const _Float16 ch = (_Float16)(i < 4 ? C0[i & 3] : C1[i & 3]); const h16x2 cf2 = {ch, ch}; \
        _Pragma("unroll") for (int w = 0; w < 4; ++w) { ya[2 * w] += cf2 * __builtin_amdgcn_cvt_scalef32_pk_f16_fp8(D[i][w], 1.0f, false); ya[2 * w + 1] += cf2 * __builtin_amdgcn_cvt_scalef32_pk_f16_fp8(D[i][w], 1.0f, true); } } } while (0)
    for (int s_ = 0; s_ < 32 * NREP_V; ++s_) { const int s = s_ & 31;
        const char* vb = VQ + s * 128 + sub * 16;
        v4u dA[8], dB[8];
        const int jend = (s & 7) == wave ? 72 : 64;
        VLOAD(dA, wave, 0);
#pragma unroll 1
        for (int jj = wave; jj < jend; jj += 8) { const int j = jj < 64 ? jj : 64;
            VLOAD(dB, j, 1);
            float* yp = Y + ((size_t)F.bid + 256 * j) * DM + 128 * s + 16 * sub + 8 * (pg >> 2);
            f32x4 x0 = {0.f, 0.f, 0.f, 0.f}, x1 = {0.f, 0.f, 0.f, 0.f};
            const bool wr = (pg & 3) == 0 && s_ >= 32 * (NREP_V - 1);
            if (wr) { x0 = *(const f32x4*)yp; x1 = *(const f32x4*)(yp + 4); }
            const f32x4 c0 = *(const f32x4*)(cf_s + j * 128 + pg * 16), c1 = *(const f32x4*)(cf_s + j * 128 + pg * 16 + 4), c2 = *(const f32x4*)(cf_s + j * 128 + pg * 16 + 8), c3 = *(const f32x4*)(cf_s + j * 128 + pg * 16 + 12);
            h16x2 ya[8];
#pragma unroll
            for (int e = 0; e < 8; ++e) ya[e] = (h16x2){(_Float16)0.f, (_Float16)0.f};
            VCOMP(dA, c0, c1);
            if (jj + 8 < jend) VLOAD(dA, (jj + 8 < 64 ? jj + 8 : 64), 0);
            VCOMP(dB, c2, c3);
            float r8[8];
#pragma unroll
            for (int e = 0; e < 4; ++e) {
                { auto rr = __builtin_amdgcn_permlane32_swap(__float_as_uint((float)ya[e].x), __float_as_uint((float)ya[e + 4].x), false, false); r8[2 * e] = __uint_as_float(rr[0]) + __uint_as_float(rr[1]); }
                { auto rr = __builtin_amdgcn_permlane32_swap(__float_as_uint((float)ya[e].y), __float_as_uint((float)ya[e + 4].y), false, false); r8[2 * e + 1] = __uint_as_float(rr[0]) + __uint_as_float(rr[1]); } }
#pragma unroll
            for (int e = 0; e < 8; ++e) { float v = r8[e]; v += xor16(v); v += xor8(v); r8[e] = v; }
            if (wr) {
                *(f32x4*)yp = (f32x4){fmaf(ALPHA_RES, x0[0], r8[0]), fmaf(ALPHA_RES, x0[1], r8[1]), fmaf(ALPHA_RES, x0[2], r8[2]), fmaf(ALPHA_RES, x0[3], r8[3])};
                *(f32x4*)(yp + 4) = (f32x4){fmaf(ALPHA_RES, x1[0], r8[4]), fmaf(ALPHA_RES, x1[1], r8[5]), fmaf(ALPHA_RES, x1[2], r8[6]), fmaf(ALPHA_RES, x1[3], r8[7])}; }
        }
    }
#undef VLOAD
#undef VCOMP
    VM_WAIT(); __syncthreads(); __builtin_amdgcn_fence(__ATOMIC_ACQUIRE, "agent"); VM_WAIT();
    for (int q = 0; q < 9; ++q) { const int j = wave + 8 * q; if (j >= 65) break;
        float* yr = Y + ((size_t)F.bid + 256 * j) * DM; f32x4 v[16]; float s = 0.f;
#pragma unroll
        for (int k = 0; k < 16; ++k) { v[k] = *(const f32x4*)(yr + 4 * (lane + 64 * k)); s += (v[k][0] + v[k][1]) + (v[k][2] + v[k][3]); }
        const float mean = wave_sum(s) * (1.f / DM); float s2 = 0.f;
#pragma unroll
        for (int k = 0; k < 16; ++k) { v[k] = v[k] - mean; s2 += (v[k][0] * v[k][0] + v[k][1] * v[k][1]) + (v[k][2] * v[k][2] + v[k][3] * v[k][3]); }
        const float rstd = rsqrtf(wave_sum(s2) * (1.f / DM) + LN_EPS);
#pragma unroll
        for (int k = 0; k < 16; ++k) { const int c = 4 * (lane + 64 * k); const f32x4 g = *(const f32x4*)(F.ln2g + c), bb = *(const f32x4*)(F.ln2b + c); *(f32x4*)(yr + c) = v[k] * rstd * g + bb; }
    }
}
#ifndef MK_N_LAUNCHES
#define MK_N_LAUNCHES 1
#endif
constexpr int NPH = 10;
struct Args { const float* in[24]; float* out; unsigned char* ws; int ph_lo, ph_hi; };
__global__ void __launch_bounds__(NWAVES * 64, 2) fwd_kernel(Args args) {
    extern __shared__ __attribute__((aligned(16))) unsigned char lds[];
    Frame F;
    F.lds = lds; F.wave = __builtin_amdgcn_readfirstlane((int)threadIdx.x >> 6); F.G = gridDim.x; F.bid = blockIdx.x;
    F.ws = args.ws; F.out = args.out; F.ctl = (gu32*)(args.ws + WS_CTL);
    F.x_p = args.in[0]; F.x_s = args.in[1]; F.cache_k = args.in[2]; F.cache_v = args.in[3]; F.state = args.in[4]; F.w_in = args.in[5]; F.w_gate2 = args.in[6]; F.b_gate = args.in[7];
    F.lq1 = args.in[8]; F.lk1 = args.in[9]; F.lq2 = args.in[10]; F.lk2 = args.in[11]; F.dng = args.in[12]; F.gng = args.in[13]; F.w_out = args.in[14];
    F.ln1g = args.in[15]; F.ln1b = args.in[16]; F.ln2g = args.in[17]; F.ln2b = args.in[18]; F.peer_wq = args.in[19]; F.keys1 = args.in[20]; F.keys2 = args.in[21]; F.peer_u = args.in[22]; F.peer_v = args.in[23];
    for (int u = ((int)threadIdx.x); u < (LDS_BYTES - MISC_OFF) / 4; u += NWAVES * 64) ((unsigned*)(lds + MISC_OFF))[u] = 0u;
    __syncthreads();
    const int lo = args.ph_lo, hi = args.ph_hi;
    XcdBarrier bar; bar.bar = (unsigned*)(F.ctl + CW_BAR); bar.x = 0; bar.st = nullptr;
    if (hi - lo > 1) bar = xcd_barrier_post((unsigned*)(F.ctl + CW_BAR), (volatile LAS unsigned*)(lds + MISC_OFF));
#ifndef PH_MASK
#define PH_MASK 0x3ff
#endif
#define IN(k) (((PH_MASK >> (k)) & 1) && lo <= (k) && (k) < hi)
#define SEAM(k) do { if (IN(k) && IN((k) + 1)) xcd_barrier(bar); } while (0)
    PG8_LAS unsigned char* glds = (PG8_LAS unsigned char*)lds;
#ifndef REPMASK
#define REPMASK 0
#endif
#define REP(k) ((REPMASK >> (k)) & 1)
    if (IN(0)) { p0_prologue(F); if (REP(0)) p0_prologue(F); SEAM(0); }
    if (IN(1)) {
        pg8::Gemm g{(const pg8::bf16_t*)(F.ws + WS_A), (const pg8::bf16_t*)(F.ws + WS_B), MTOK, NPROJ_PAD, DM}; pg8::StaticOrder S; S.init(MTOK, NPROJ_PAD, F.G, F.bid);
        pg8::EpiProj E;
        E.QKV = (pg8::bf16_t*)(F.ws + WS_C); E.GB = (pg8::bf16_t*)(F.ws + WS_D);
        E.GZ = (float*)(F.ws + WS_GZ); E.outKp = F.out + O_KP; E.outKs = F.out + O_KS; E.outVp = F.out + O_VP; E.outVs = F.out + O_VS; E.rope = (const float*)(F.ws + WS_ROPE);
        pg8::gemm_phase<pg8::EpiProj, pg8::StaticOrder, true, true>(glds, g, S, E, F.wave * 64 + lane_id_v());
        if (REP(1)) pg8::gemm_phase<pg8::EpiProj, pg8::StaticOrder, true, true>(glds, g, S, E, F.wave * 64 + lane_id_v());
        if ((long)12 * F.G + F.bid >= (long)(MTOK / 256) * (NPROJ_PAD / 256)) cvt_cache_drain(F, 2);
        SEAM(1);
    }
    if (IN(2)) { cvt_cache_drain(F, 144); p2_gla_prep(F); if (REP(2)) p2_gla_prep(F); SEAM(2); }
    if (IN(3)) { p3_attn_scan(F); SEAM(3); }
    if (IN(4)) { if (REP(4)) p3b_finalize(F, true); p3b_finalize(F, false); SEAM(4); }
    if (IN(5)) {
        pg8::Gemm g{(const pg8::bf16_t*)(F.ws + WS_F), (const pg8::bf16_t*)(F.ws + WS_WOUT), MTOK, DM, DM}; pg8::StaticOrder S; S.init(MTOK, DM, F.G, F.bid);
        pg8::EpiMix E{F.x_p, F.x_s, F.out + O_Y, ALPHA_RES};
        pg8::gemm_phase<pg8::EpiMix, pg8::StaticOrder, true, true>(glds, g, S, E, F.wave * 64 + lane_id_v());
        if (REP(5)) pg8::gemm_phase<pg8::EpiMix, pg8::StaticOrder, true, true>(glds, g, S, E, F.wave * 64 + lane_id_v());
        if ((long)4 * F.G + F.bid >= (long)(MTOK / 256) * (DM / 256)) cvt_tables_drain(F, 3);
        SEAM(5);
    }
    if (IN(6)) { if (REP(6)) p5_ln1(F, true); p5_ln1(F, false); SEAM(6); }
    if (IN(7)) {
        pg8::Gemm g{(const pg8::bf16_t*)(F.ws + WS_A), (const pg8::bf16_t*)(F.ws + WS_WQ), MTOK, 2048, DM}; pg8::StaticOrder S; S.init(MTOK, 2048, F.G, F.bid);
        pg8::EpiBf16<0> E{(pg8::bf16_t*)(F.ws + WS_B), 2048, nullptr, 0, 0, 1.f};
        pg8::gemm_phase<pg8::EpiBf16<0>, pg8::StaticOrder, true, true>(glds, g, S, E, F.wave * 64 + lane_id_v());
        if (REP(7)) pg8::gemm_phase<pg8::EpiBf16<0>, pg8::StaticOrder, true, true>(glds, g, S, E, F.wave * 64 + lane_id_v());
        if ((long)2 * F.G + F.bid >= (long)(MTOK / 256) * (2048 / 256)) cvt_tables_drain(F, 3);
        SEAM(7);
    }
    if (IN(8)) { p7_peer_select(F); if (REP(8)) p7_peer_select(F); cvt_tables_drain(F, 512); SEAM(8); }
    if (IN(9)) { p8_peer_gather(F); }
#undef IN
#undef SEAM
}

extern "C" void kernel_launch(void* const* d_in, const int* in_sizes, int n_in, void* d_out, int out_size, void* d_ws, size_t ws_size, hipStream_t stream) {
    static int grid = 0;
    if (grid == 0) {
        if (n_in != 24 || ws_size < WS_END) { fprintf(stderr, "kernel_launch: need 24 inputs and >= %zu bytes of workspace; got %d, %zu\n", (size_t)WS_END, n_in, ws_size); grid = -1; return; }
        int dev = 0, cus = 0, per_cu = 0;
        if (hipGetDevice(&dev) != hipSuccess || hipDeviceGetAttribute(&cus, hipDeviceAttributeMultiprocessorCount, dev) != hipSuccess) { grid = -1; return; }
        if (hipFuncSetAttribute((const void*)fwd_kernel, hipFuncAttributeMaxDynamicSharedMemorySize, LDS_BYTES) != hipSuccess) { fprintf(stderr, "kernel_launch: hipFuncSetAttribute failed\n"); grid = -1; return; }
        if (hipOccupancyMaxActiveBlocksPerMultiprocessor(&per_cu, (const void*)fwd_kernel, NWAVES * 64, LDS_BYTES) != hipSuccess || per_cu < 1) { fprintf(stderr, "kernel_launch: occupancy query says %d\n", per_cu); }
        (void)hipGetLastError();
        if (cus < 256) { fprintf(stderr, "kernel_launch: built for a 256-CU device (MI355X); this one reports %d CUs\n", cus); grid = -1; return; }
        grid = 256;
    }
    if (grid < 0) return;
    (void)hipMemsetAsync((char*)d_ws + WS_CTL, 0, CTL_ZERO_BYTES, stream);
    Args a{};
    for (int i = 0; i < 24; ++i) a.in[i] = (const float*)d_in[i];
    a.out = (float*)d_out; a.ws = (unsigned char*)d_ws;
#if MK_N_LAUNCHES == 1
    a.ph_lo = 0; a.ph_hi = NPH;
    hipLaunchKernelGGL(fwd_kernel, dim3(grid), dim3(NWAVES * 64), LDS_BYTES, stream, a);
#else
    for (int p = 0; p < NPH; ++p) { a.ph_lo = p; a.ph_hi = p + 1; hipLaunchKernelGGL(fwd_kernel, dim3(grid), dim3(NWAVES * 64), LDS_BYTES, stream, a); }
#endif
    const hipError_t le = hipPeekAtLastError();
    if (le != hipSuccess) fprintf(stderr, "kernel_launch: launch failed: %s\n", hipGetErrorName(le));
}
```

```cpp
#include <hip/hip_runtime.h>
#include <cstdio>
#include <cstdint>
namespace pg8 {
#define PG8_LAS __attribute__((address_space(3)))
typedef unsigned short bf16_t;
typedef short bf16x8 __attribute__((ext_vector_type(8)));
typedef float f32x4 __attribute__((ext_vector_type(4)));
typedef unsigned u32x4 __attribute__((ext_vector_type(4)));
constexpr int BM = 256, BK = 64, HALF = 128, HTB = HALF * BK * 2  , STAGE_BYTES = 8 * HTB, NXCD = 8, WGM = 8;

__host__ __device__ __forceinline__ int lds_byte(int r, int c) { const int st = (r >> 4) * 2 + (c >> 5), rr = r & 15, cc = c & 31, ob = rr * 64 + cc * 2; return st * 1024 + (ob ^ (((ob >> 9) & 1) << 5)); }
__host__ __device__ __forceinline__ void stage_rc(int b, int& R, int& C) { const int st = b / 1024, sb = b % 1024, swz = sb ^ (((sb >> 9) & 1) << 5); R = (st >> 1) * 16 + swz / 64; C = (st & 1) * 32 + (swz % 64) / 2; }
__host__ __device__ __forceinline__ int perm32(int rho) { const int n = rho >> 4, i = rho & 15; return 8 * (i >> 2) + 4 * n + (i & 3); }

struct Unit { int pm, pn, mask; };
struct Gemm { const bf16_t* A; const bf16_t* Bt; int M, N, K; };

struct StaticOrder {
    int nM, nN, nwg, G, c, ibeg, iend;
    __host__ __device__ void init(int M, int N, int G_, int c_) { nM = M / BM; nN = N / BM; nwg = nM * nN; G = G_; c = c_; ibeg = 0; iend = 1 << 30; }
    __host__ __device__ bool next(int i, Unit& u) const {
        i += ibeg; if (i >= iend) return false;
        const long L = (long)i * G + c; if (L >= nwg) return false;
        int wgid = (int)L; { const int q = nwg / NXCD, r = nwg % NXCD, xcd = wgid % NXCD, off = wgid / NXCD; wgid = (xcd < r ? xcd * (q + 1) : r * (q + 1) + (xcd - r) * q) + off; }
        const int nig = WGM * nN, gid = wgid / nig, fm = gid * WGM, gsz = (nM - fm) < WGM ? (nM - fm) : WGM;
        u.pm = fm + ((wgid % nig) % gsz); u.pn = (wgid % nig) / gsz; u.mask = 15; return true;
    }
    __device__ __forceinline__ void a_ready(const Unit&) const {}
    __device__ __forceinline__ void done(const Unit&) const {}
};

__device__ __forceinline__ unsigned cvt_pk_bf16(float lo, float hi) { unsigned r; asm volatile("v_cvt_pk_bf16_f32 %0, %1, %2" : "=v"(r) : "v"(lo), "v"(hi)); return r; }
typedef float f32x2 __attribute__((ext_vector_type(2)));
__device__ __forceinline__ f32x2 gelu_pk(f32x2 v) {
    const f32x2 av = __builtin_elementwise_abs(v), d = av * 0.2316418882f + 1.0f;
    f32x2 t; t.x = __builtin_amdgcn_rcpf(d.x); t.y = __builtin_amdgcn_rcpf(d.y);
    f32x2 q = t * 0.5307027145f + (-0.7265760135f); q = q * t + 0.7107068705f; q = q * t + (-0.142248368f); q = q * t + 0.127414796f; q = q * t;
    const f32x2 s = (v * v) * (-0.72134752044f);
    f32x2 e; e.x = __builtin_amdgcn_exp2f(s.x); e.y = __builtin_amdgcn_exp2f(s.y);
    const f32x2 m = v * (q * e), r = v - m;
    f32x2 o; o.x = v.x < 0.f ? m.x : r.x; o.y = v.y < 0.f ? m.y : r.y; return o;
}

template <int ACT  > struct EpiBf16 {
    static constexpr bool PERM = true, AFTER_DRAIN = false; static_assert(ACT == 0 || ACT == 1, "EpiBf16: ACT is 0 (none) or 1 (gelu_pk)");
    bf16_t* O; int ldc; const float* bias; int split_cols; size_t split_stride; float scale0;
    __device__ __forceinline__ void operator()(const f32x4 (&acc)[2][2][4][2], const Unit& u, int wr, int wc, int fr, int fq) const {
        const int row0 = u.pm * BM + wr * 64 + fr; int colt = u.pn * BM; bf16_t* base = O;
        float sc = 1.f; if (split_cols) { const int t = colt / split_cols; base += (size_t)t * split_stride; colt -= t * split_cols; if (t == 0) sc = scale0; }
        const int col0 = colt + wc * 32 + 8 * fq, bcol0 = u.pn * BM + wc * 32 + 8 * fq;
        f32x4 bv[2][2];
#pragma unroll
        for (int bj = 0; bj < 2; ++bj)
#pragma unroll
            for (int n = 0; n < 2; ++n) bv[bj][n] = bias ? *(const f32x4*)(bias + bcol0 + bj * HALF + 4 * n) : (f32x4){0.f, 0.f, 0.f, 0.f};
#pragma unroll
        for (int ai = 0; ai < 2; ++ai)
#pragma unroll
            for (int m = 0; m < 4; ++m) { bf16_t* rowp = base + (size_t)(row0 + ai * HALF + m * 16) * ldc + col0;
#pragma unroll
                for (int bj = 0; bj < 2; ++bj) { if (!((u.mask >> (2 * ai + bj)) & 1)) continue; f32x4 v0 = acc[ai][bj][m][0] + bv[bj][0], v1 = acc[ai][bj][m][1] + bv[bj][1];
                    if (ACT == 1) { f32x2 a = gelu_pk((f32x2){v0[0], v0[1]}), b = gelu_pk((f32x2){v0[2], v0[3]}), c = gelu_pk((f32x2){v1[0], v1[1]}), d = gelu_pk((f32x2){v1[2], v1[3]});
                        v0 = (f32x4){a.x, a.y, b.x, b.y}; v1 = (f32x4){c.x, c.y, d.x, d.y}; }
                    v0 = v0 * sc; v1 = v1 * sc; u32x4 w; w.x = cvt_pk_bf16(v0[0], v0[1]); w.y = cvt_pk_bf16(v0[2], v0[3]); w.z = cvt_pk_bf16(v1[0], v1[1]); w.w = cvt_pk_bf16(v1[2], v1[3]);
                    *(u32x4*)(rowp + bj * HALF) = w; } }
    }
};
typedef unsigned u32x2 __attribute__((ext_vector_type(2)));
struct EpiProj {
    static constexpr bool PERM = true, AFTER_DRAIN = false;
    bf16_t *QKV, *GB; float* GZ;
    float *outKp, *outKs, *outVp, *outVs; const float* rope; int pn0;
    __device__ __forceinline__ void operator()(const f32x4 (&acc)[2][2][4][2], const Unit& u, int wr, int wc, int fr, int fq) const {
        const int pn = u.pn + pn0; const int row0 = u.pm * BM + wr * 64 + fr;
        if (pn < 16) {
            const bool isk = pn >= 8; const int hb = (pn & 7) * 256, i0 = 16 * wc + 4 * fq;
            bf16_t* dstb = QKV + (isk ? (size_t)16640 * 2048 : (size_t)0);
#pragma unroll
            for (int ai = 0; ai < 2; ++ai) {
                f32x4 rr0[4], rr1[4];
#pragma unroll
                for (int m = 0; m < 4; ++m) { const int row = row0 + ai * HALF + m * 16; const int pos = row < 16384 ? (row & 8191) : 1024 + ((row - 16384) & 15);
                    const f32x4* rp = (const f32x4*)(rope + (size_t)pos * 128 + 2 * i0); rr0[m] = rp[0]; rr1[m] = rp[1]; }
#pragma unroll
                for (int m = 0; m < 4; ++m) {
                    const int row = row0 + ai * HALF + m * 16;
                    const f32x4 r0 = rr0[m], r1 = rr1[m];
                    float* okrow = row < 16384 ? outKp + (size_t)row * 2048 : outKs + (size_t)(row - 16384) * 2048;
#pragma unroll
                    for (int bj = 0; bj < 2; ++bj) { if (!((u.mask >> (2 * ai + bj)) & 1)) continue;
                        const f32x4 v0 = acc[ai][bj][m][0], v1 = acc[ai][bj][m][1];
                        f32x4 lo, hi;
                        lo[0] = v0[0] * r0[0] - v0[1] * r0[1]; hi[0] = v0[1] * r0[0] + v0[0] * r0[1];
                        lo[1] = v0[2] * r0[2] - v0[3] * r0[3]; hi[1] = v0[3] * r0[2] + v0[2] * r0[3];
                        lo[2] = v1[0] * r1[0] - v1[1] * r1[1]; hi[2] = v1[1] * r1[0] + v1[0] * r1[1];
                        lo[3] = v1[2] * r1[2] - v1[3] * r1[3]; hi[3] = v1[3] * r1[2] + v1[2] * r1[3];
                        const int col = hb + bj * HALF + i0;
                        u32x2 wl, wh; wl.x = cvt_pk_bf16(lo[0], lo[1]); wl.y = cvt_pk_bf16(lo[2], lo[3]); wh.x = cvt_pk_bf16(hi[0], hi[1]); wh.y = cvt_pk_bf16(hi[2], hi[3]);
                        *(u32x2*)(dstb + (size_t)row * 2048 + col) = wl; *(u32x2*)(dstb + (size_t)row * 2048 + col + 64) = wh;
                        if (isk) { __builtin_nontemporal_store(lo, (f32x4*)(okrow + col)); __builtin_nontemporal_store(hi, (f32x4*)(okrow + col + 64)); }
                    }
                }
            }
        } else if (pn < 24) {
            const int col0 = (pn - 16) * 256 + wc * 32 + 8 * fq;
#pragma unroll
            for (int ai = 0; ai < 2; ++ai)
#pragma unroll
                for (int m = 0; m < 4; ++m) {
                    const int row = row0 + ai * HALF + m * 16;
                    float* ovrow = row < 16384 ? outVp + (size_t)row * 2048 : outVs + (size_t)(row - 16384) * 2048;
#pragma unroll
                    for (int bj = 0; bj < 2; ++bj) { if (!((u.mask >> (2 * ai + bj)) & 1)) continue;
                        const f32x4 v0 = acc[ai][bj][m][0], v1 = acc[ai][bj][m][1]; const int col = col0 + bj * HALF;
                        __builtin_nontemporal_store(v0, (f32x4*)(ovrow + col)); __builtin_nontemporal_store(v1, (f32x4*)(ovrow + col + 4));
                        u32x4 w; w.x = cvt_pk_bf16(v0[0], v0[1]); w.y = cvt_pk_bf16(v0[2], v0[3]); w.z = cvt_pk_bf16(v1[0], v1[1]); w.w = cvt_pk_bf16(v1[2], v1[3]);
                        *(u32x4*)(QKV + (size_t)2 * 16640 * 2048 + (size_t)row * 2048 + col) = w;
                    }
                }
        } else if (pn < 48) {
            size_t eoff; int ld, colt;
            if (pn < 28) { eoff = 0; ld = 1024; colt = (pn - 24) * 256; }
            else if (pn < 32) { eoff = (size_t)16640 * 1024; ld = 1024; colt = (pn - 28) * 256; }
            else if (pn < 40) { eoff = (size_t)16640 * 2048; ld = 2048; colt = (pn - 32) * 256; }
            else { eoff = (size_t)16640 * 4096; ld = 2048; colt = (pn - 40) * 256; }
            bf16_t* base = GB + eoff;
            const int col0 = colt + wc * 32 + 8 * fq;
#pragma unroll
            for (int ai = 0; ai < 2; ++ai)
#pragma unroll
                for (int m = 0; m < 4; ++m) {
                    const int row = row0 + ai * HALF + m * 16;
#pragma unroll
                    for (int bj = 0; bj < 2; ++bj) { if (!((u.mask >> (2 * ai + bj)) & 1)) continue;
                        const f32x4 v0 = acc[ai][bj][m][0], v1 = acc[ai][bj][m][1];
                        u32x4 w; w.x = cvt_pk_bf16(v0[0], v0[1]); w.y = cvt_pk_bf16(v0[2], v0[3]); w.z = cvt_pk_bf16(v1[0], v1[1]); w.w = cvt_pk_bf16(v1[2], v1[3]);
                        *(u32x4*)(base + (size_t)row * ld + col0 + bj * HALF) = w;
                    }
                }
        } else {
            if (wc == 0 && fq < 2) {
#pragma unroll
                for (int ai = 0; ai < 2; ++ai)
#pragma unroll
                    for (int m = 0; m < 4; ++m) { if (!((u.mask >> (2 * ai)) & 1)) continue;
                        const int row = row0 + ai * HALF + m * 16;
                        *(f32x4*)(GZ + (size_t)row * 16 + 8 * fq) = acc[ai][0][m][0]; *(f32x4*)(GZ + (size_t)row * 16 + 8 * fq + 4) = acc[ai][0][m][1];
                    }
            }
        }
    }
};
struct EpiMix {
    static constexpr bool PERM = true, AFTER_DRAIN = false;
    const float* xp; const float* xs; bf16_t* O; float alpha;
    __device__ __forceinline__ void operator()(const f32x4 (&acc)[2][2][4][2], const Unit& u, int wr, int wc, int fr, int fq) const {
        const int row0 = u.pm * BM + wr * 64 + fr, col0 = u.pn * BM + wc * 32 + 8 * fq;
#pragma unroll
        for (int ai = 0; ai < 2; ++ai)
#pragma unroll
            for (int m = 0; m < 4; ++m) {
                const int row = row0 + ai * HALF + m * 16;
                const float* xr = (row < 16384 ? xp + (size_t)row * 4096 : xs + (size_t)(row - 16384) * 4096) + col0;
                bf16_t* orow = O + (size_t)row * 4096 + col0;
#pragma unroll
                for (int bj = 0; bj < 2; ++bj) { if (!((u.mask >> (2 * ai + bj)) & 1)) continue;
                    const f32x4 x0 = *(const f32x4*)(xr + bj * HALF), x1 = *(const f32x4*)(xr + bj * HALF + 4);
                    const f32x4 v0 = acc[ai][bj][m][0] + alpha * x0, v1 = acc[ai][bj][m][1] + alpha * x1;
                    u32x4 w; w.x = cvt_pk_bf16(v0[0], v0[1]); w.y = cvt_pk_bf16(v0[2], v0[3]); w.z = cvt_pk_bf16(v1[0], v1[1]); w.w = cvt_pk_bf16(v1[2], v1[3]);
                    *(u32x4*)(orow + bj * HALF) = w; }
            }
    }
};
template <class Epi, class Sched, bool ALIGN_EPI = false, bool SP2 = false>
__device__ __forceinline__ void gemm_phase(PG8_LAS unsigned char* lds, const Gemm g, const Sched& S, const Epi& E, int tid_in) {
    const int tid_ = tid_in;
    const int tid = tid_, wid = __builtin_amdgcn_readfirstlane(tid >> 6), lane = tid & 63, wr = wid >> 2, wc = wid & 3, fr = lane & 15, fq = lane >> 4;
    const int K = g.K, nt = K / BK;
    unsigned voffA[2], voffB[2];
#pragma unroll
    for (int i = 0; i < 2; ++i) { int R, C; stage_rc(tid * 16 + i * 8192, R, C); const int Rb = Epi::PERM ? ((R & ~31) + perm32(R & 31)) : R;
        voffA[i] = (unsigned)(R * K + C) * 2u; voffB[i] = (unsigned)(Rb * K + C) * 2u; }
    const size_t kstep = (size_t)(BK * 2);
    const size_t hstep = (size_t)HALF * K * 2;
    const size_t tstep = 2 * hstep;
    const unsigned ldsw = (unsigned)wid * 1024u;
    const int aoff = lds_byte(wr * 64 + fr, fq * 8), boff = lds_byte(wc * 32 + fr, fq * 8);
#define PG8_SA(b, h) (((b) * 2 + (h)) * HTB)
#define PG8_SB(b, h) ((4 + (b) * 2 + (h)) * HTB)
#define PG8_STAGE(bufoff, gbase, voff) do { _Pragma("unroll") for (int _i = 0; _i < 2; ++_i) \
        __builtin_amdgcn_global_load_lds((const unsigned*)((const char*)(gbase) + (voff)[_i]), (PG8_LAS unsigned*)(lds + (bufoff) + ldsw + _i * 8192), 16, 0, 0); } while (0)
#define PG8_LDA(dst, b, h) do { _Pragma("unroll") for (int m = 0; m < 4; ++m) _Pragma("unroll") for (int k = 0; k < 2; ++k) dst[m][k] = *(const PG8_LAS bf16x8*)(lds + PG8_SA(b, h) + aoff + m * 2048 + k * 1024); } while (0)
#define PG8_LDB(dst, b, h) do { _Pragma("unroll") for (int n = 0; n < 2; ++n) _Pragma("unroll") for (int k = 0; k < 2; ++k) dst[n][k] = *(const PG8_LAS bf16x8*)(lds + PG8_SB(b, h) + boff + n * 2048 + k * 1024); } while (0)
#define PG8_MMA(ai, bj, At, Bt) do { __builtin_amdgcn_s_setprio(1); _Pragma("unroll") for (int m = 0; m < 4; ++m) _Pragma("unroll") for (int n = 0; n < 2; ++n) _Pragma("unroll") for (int k = 0; k < 2; ++k) \
        acc[ai][bj][m][n] = __builtin_amdgcn_mfma_f32_16x16x32_bf16(Bt[n][k], At[m][k], acc[ai][bj][m][n], 0, 0, 0); __builtin_amdgcn_s_setprio(0); } while (0)
#define PG8_WAIT_V(n) asm volatile("s_waitcnt vmcnt(" #n ")" ::: "memory")
#define PG8_WAIT_L(n) asm volatile("s_waitcnt lgkmcnt(" #n ")" ::: "memory")
#define PG8_BAR __builtin_amdgcn_s_barrier()
#define PG8_SCHED __builtin_amdgcn_sched_barrier(0)
    Unit cur, nxt; int ui = 0;
    if (!S.next(0, cur)) return;
    f32x4 acc[2][2][4][2];
#pragma unroll
    for (int a = 0; a < 2; ++a)
#pragma unroll
        for (int b = 0; b < 2; ++b)
#pragma unroll
            for (int m = 0; m < 4; ++m)
#pragma unroll
                for (int n = 0; n < 2; ++n) acc[a][b][m][n] = (f32x4){0.f, 0.f, 0.f, 0.f};
    bf16x8 At[4][2], B0[2][2], B1[2][2];
    const char* cA = (const char*)g.A + (size_t)cur.pm * tstep; const char* cB = (const char*)g.Bt + (size_t)cur.pn * tstep;
    S.a_ready(cur);
    if constexpr (SP2) {
        PG8_STAGE(PG8_SB(0, 0), cB, voffB); PG8_STAGE(PG8_SB(0, 1), cB + hstep, voffB); PG8_STAGE(PG8_SA(0, 0), cA, voffA); PG8_STAGE(PG8_SA(0, 1), cA + hstep, voffA);
        if (wr == 1) PG8_BAR;
        PG8_WAIT_V(2); PG8_BAR;
        PG8_STAGE(PG8_SB(1, 0), cB + kstep, voffB); PG8_STAGE(PG8_SA(1, 0), cA + kstep, voffA); PG8_STAGE(PG8_SB(1, 1), cB + hstep + kstep, voffB);
        PG8_WAIT_V(6); PG8_BAR;
    } else {
        PG8_STAGE(PG8_SB(0, 0), cB, voffB); PG8_STAGE(PG8_SA(0, 0), cA, voffA); PG8_STAGE(PG8_SB(0, 1), cB + hstep, voffB); PG8_STAGE(PG8_SA(0, 1), cA + hstep, voffA);
        if (wr == 1) PG8_BAR;
        PG8_WAIT_V(4); PG8_BAR;
        PG8_STAGE(PG8_SB(1, 0), cB + kstep, voffB); PG8_STAGE(PG8_SA(1, 0), cA + kstep, voffA); PG8_STAGE(PG8_SB(1, 1), cB + hstep + kstep, voffB);
        PG8_WAIT_V(6); PG8_BAR;
    }
    for (;;) {
        const bool has_next = S.next(ui + 1, nxt);
        const char* nA = has_next ? (const char*)g.A + (size_t)nxt.pm * tstep : cA; const char* nB = has_next ? (const char*)g.Bt + (size_t)nxt.pn * tstep : cB;
        for (int t = 0; t < nt; t += 2) {
            const bool last = (t == nt - 2);
            const char* a1 = cA + (size_t)(t + 1) * kstep;
            const char* a2 = last ? nA : cA + (size_t)(t + 2) * kstep; const char* b2 = last ? nB : cB + (size_t)(t + 2) * kstep;
            const char* a3 = a2 + kstep; const char* b3 = b2 + kstep;
            if (last && has_next) S.a_ready(nxt);
            if constexpr (SP2) {
            PG8_LDB(B0, 0, 0); PG8_LDB(B1, 0, 1); PG8_SCHED; PG8_LDA(At, 0, 0); PG8_STAGE(PG8_SA(1, 1), a1 + hstep, voffA);
            PG8_WAIT_V(8); PG8_WAIT_L(0); PG8_BAR; PG8_MMA(0, 0, At, B0); PG8_MMA(0, 1, At, B1); PG8_BAR; PG8_SCHED;
            PG8_LDA(At, 0, 1); PG8_STAGE(PG8_SB(0, 0), b2, voffB); PG8_STAGE(PG8_SB(0, 1), b2 + hstep, voffB); PG8_STAGE(PG8_SA(0, 0), a2, voffA);
            PG8_WAIT_V(8); PG8_WAIT_L(0); PG8_BAR; PG8_MMA(1, 0, At, B0); PG8_MMA(1, 1, At, B1); PG8_BAR; PG8_SCHED;
            PG8_LDB(B0, 1, 0); PG8_LDB(B1, 1, 1); PG8_SCHED; PG8_LDA(At, 1, 0); PG8_STAGE(PG8_SA(0, 1), a2 + hstep, voffA);
            PG8_WAIT_V(8); PG8_WAIT_L(0); PG8_BAR; PG8_MMA(0, 0, At, B0); PG8_MMA(0, 1, At, B1); PG8_BAR; PG8_SCHED;
            PG8_LDA(At, 1, 1); PG8_STAGE(PG8_SB(1, 0), b3, voffB); PG8_STAGE(PG8_SB(1, 1), b3 + hstep, voffB); PG8_STAGE(PG8_SA(1, 0), a3, voffA);
            PG8_WAIT_V(8); PG8_WAIT_L(0); PG8_BAR; PG8_MMA(1, 0, At, B0); PG8_MMA(1, 1, At, B1); PG8_BAR; PG8_SCHED;
            } else {
            PG8_LDB(B0, 0, 0); PG8_SCHED; PG8_LDA(At, 0, 0); PG8_STAGE(PG8_SA(1, 1), a1 + hstep, voffA);
            PG8_WAIT_L(8); PG8_BAR; PG8_WAIT_L(0); PG8_MMA(0, 0, At, B0); PG8_BAR; PG8_SCHED;
            PG8_LDB(B1, 0, 1); PG8_STAGE(PG8_SB(0, 0), b2, voffB);
            PG8_BAR; PG8_WAIT_L(0); PG8_MMA(0, 1, At, B1); PG8_BAR;
            PG8_LDA(At, 0, 1); PG8_STAGE(PG8_SA(0, 0), a2, voffA);
            PG8_BAR; PG8_WAIT_L(0); PG8_MMA(1, 0, At, B0); PG8_BAR; PG8_SCHED;
            PG8_STAGE(PG8_SB(0, 1), b2 + hstep, voffB);
            PG8_WAIT_V(6); PG8_BAR; PG8_MMA(1, 1, At, B1); PG8_BAR;
            PG8_LDB(B0, 1, 0); PG8_SCHED; PG8_LDA(At, 1, 0); PG8_STAGE(PG8_SA(0, 1), a2 + hstep, voffA);
            PG8_WAIT_L(8); PG8_BAR; PG8_WAIT_L(0); PG8_MMA(0, 0, At, B0); PG8_BAR; PG8_SCHED;
            PG8_LDB(B1, 1, 1); PG8_STAGE(PG8_SB(1, 0), b3, voffB);
            PG8_BAR; PG8_WAIT_L(0); PG8_MMA(0, 1, At, B1); PG8_BAR;
            PG8_LDA(At, 1, 1); PG8_STAGE(PG8_SA(1, 0), a3, voffA);
            PG8_BAR; PG8_WAIT_L(0); PG8_MMA(1, 0, At, B0); PG8_BAR; PG8_SCHED;
            PG8_STAGE(PG8_SB(1, 1), b3 + hstep, voffB);
            PG8_WAIT_V(6); PG8_BAR; PG8_MMA(1, 1, At, B1); PG8_BAR;
            }
        }
        if constexpr (ALIGN_EPI) { if (wr == 0) PG8_BAR; }
        if constexpr (!Epi::AFTER_DRAIN) { E(acc, cur, wr, wc, fr, fq); S.done(cur); }
        if (!has_next) break;
#pragma unroll
        for (int a = 0; a < 2; ++a)
#pragma unroll
            for (int b = 0; b < 2; ++b)
#pragma unroll
                for (int m = 0; m < 4; ++m)
#pragma unroll
                    for (int n = 0; n < 2; ++n) acc[a][b][m][n] = (f32x4){0.f, 0.f, 0.f, 0.f};
        cur = nxt; cA = nA; cB = nB; ++ui;
        if constexpr (ALIGN_EPI) { if (wr == 1) PG8_BAR; }
    }
    PG8_WAIT_V(0);
    if constexpr (!ALIGN_EPI) { if (wr == 0) PG8_BAR; }
    PG8_BAR;
    if constexpr (Epi::AFTER_DRAIN) { E.fused(acc, cur, wr, wc, fr, fq, lds, wid, lane); S.done(cur); }
#undef PG8_SA
#undef PG8_SB
#undef PG8_STAGE
#undef PG8_LDA
#undef PG8_LDB
#undef PG8_MMA
#undef PG8_WAIT_V
#undef PG8_WAIT_L
#undef PG8_BAR
#undef PG8_SCHED
}
}
constexpr int DM = 4096, SEQ = 8192, TP = 16384, TSM = 256, MTOK = 16640;
constexpr int NPROJ = 12304, NPROJ_PAD = 12544;
constexpr int NWAVES = 8;
constexpr float ALPHA_RES = 1.189207115002721f, LN_EPS = 1e-5f, LAM_INIT = 0.2f;
constexpr size_t MiB = 1u << 20;
constexpr size_t WS_CTL = 0, CTL_ZERO_BYTES = 1 * MiB;
constexpr size_t WS_ROPE = 1 * MiB;
constexpr size_t WS_KEYB = 5 * MiB;
constexpr size_t WS_GZ   = 6 * MiB;
constexpr size_t WS_IDX  = 8 * MiB;
constexpr size_t WS_GATE = 17 * MiB;
constexpr size_t WS_WOUT = 26 * MiB;
constexpr size_t WS_WQ   = 58 * MiB;
constexpr size_t WS_A    = 74 * MiB;
constexpr size_t WS_B    = 204 * MiB;
constexpr size_t WS_QIN  = WS_B, WS_KENDT = WS_B + 32 * MiB, WS_AM = WS_B + 64 * MiB, WS_DEC = WS_B + 72 * MiB;
constexpr size_t WS_C    = 302 * MiB;
constexpr size_t WS_D    = 497 * MiB;
constexpr size_t WS_E    = 692 * MiB;
constexpr size_t WS_F    = 756 * MiB;
constexpr size_t WS_G    = 886 * MiB;
constexpr size_t WS_H    = 1146 * MiB;
constexpr size_t WS_END  = 1290 * MiB;
constexpr size_t SZ_TOK2048 = (size_t)MTOK * 2048 * 2;
constexpr int CW_TMO = 0, CW_QUEUE = 64, CW_BAR = 4096;
constexpr int LDS_BYTES = 163840, MISC_OFF = 159744;
constexpr size_t O_Y = 0, O_KP = 68157440, O_VP = 101711872, O_GP = 135266304, O_KS = 136314880, O_VS = 136839168, O_GS = 137363456;

#define GAS __attribute__((address_space(1)))
#define LAS __attribute__((address_space(3)))
typedef unsigned short bf16;
typedef unsigned v4u __attribute__((ext_vector_type(4)));
typedef unsigned v2u __attribute__((ext_vector_type(2)));
typedef float f32x4 __attribute__((ext_vector_type(4)));
typedef float f32x2 __attribute__((ext_vector_type(2)));
typedef float f32x16 __attribute__((ext_vector_type(16)));
typedef short bf16x8 __attribute__((ext_vector_type(8)));
typedef short s16x4 __attribute__((ext_vector_type(4)));
typedef __bf16 bf16x2_t __attribute__((ext_vector_type(2)));
typedef GAS unsigned gu32;
#define RLX_AGENT __ATOMIC_RELAXED, __HIP_MEMORY_SCOPE_AGENT
#define LDS_WAIT() asm volatile("s_waitcnt lgkmcnt(0)" ::: "memory")
#define VM_WAIT() asm volatile("s_waitcnt vmcnt(0)" ::: "memory")
__device__ __forceinline__ unsigned f2bf(float f) { unsigned u = __builtin_bit_cast(unsigned, f); return (u + 0x7fffu + ((u >> 16) & 1u)) >> 16; }
__device__ __forceinline__ unsigned pk2(float lo, float hi) { return f2bf(lo) | (f2bf(hi) << 16); }
__device__ __forceinline__ float bf2f(unsigned short b) { return __builtin_bit_cast(float, (unsigned)b << 16); }
__device__ __forceinline__ float bflo(unsigned w) { return __builtin_bit_cast(float, w << 16); }
__device__ __forceinline__ float bfhi(unsigned w) { return __builtin_bit_cast(float, w & 0xffff0000u); }
__device__ __forceinline__ int lane_id_v() { int l; asm volatile("v_mbcnt_lo_u32_b32 %0, -1, 0\n\tv_mbcnt_hi_u32_b32 %0, -1, %0" : "=v"(l)); return l; }
template <int CTRL> __device__ __forceinline__ float dppf(float v) { return __builtin_bit_cast(float, __builtin_amdgcn_update_dpp(0, __builtin_bit_cast(int, v), CTRL, 0xF, 0xF, true)); }
__device__ __forceinline__ float xor1(float v) { return dppf<0xB1>(v); }
__device__ __forceinline__ float xor2(float v) { return dppf<0x4E>(v); }
__device__ __forceinline__ float xor4s(float v) { return dppf<0x141>(v); }
__device__ __forceinline__ float xor8(float v) { return dppf<0x128>(v); }
__device__ __forceinline__ float xor16(float v) { return __builtin_bit_cast(float, __builtin_amdgcn_ds_swizzle(__builtin_bit_cast(int, v), 0x401F)); }
__device__ __forceinline__ float wave_sum(float v) {
    v += xor1(v); v += xor2(v); v += xor4s(v); v += xor8(v); v += xor16(v);
    const auto rr = __builtin_amdgcn_permlane32_swap(__float_as_uint(v), __float_as_uint(v), false, false); return __uint_as_float(rr[0]) + __uint_as_float(rr[1]);
}
__device__ __forceinline__ int crow(int r, int hi) { return (r & 3) + 8 * (r >> 2) + 4 * hi; }
#define MFMA32(a, b, c) __builtin_amdgcn_mfma_f32_32x32x16_bf16((a), (b), (c), 0, 0, 0)
#define XB_TMO      128
#define XB_XCNT(j)  (256  + 64 * (j))
#define XB_XSUB(j)  (1280 + 64 * (j))
#define XB_XGEN(j)  (2304 + 64 * (j))
#define XB_TOP      3328
#define XB_TOPGEN   3392
#define XCD_BAR_WORDS 3456
#define XB_SPIN_CAP (1u << 18)

__device__ __forceinline__ unsigned xb_ld(unsigned* p)              { return __hip_atomic_load(p, __ATOMIC_RELAXED, __HIP_MEMORY_SCOPE_AGENT); }
__device__ __forceinline__ unsigned xb_add(unsigned* p, unsigned v) { return __hip_atomic_fetch_add(p, v, __ATOMIC_RELAXED, __HIP_MEMORY_SCOPE_AGENT); }
__device__ __forceinline__ unsigned xb_xcc_id() { return (unsigned)__builtin_amdgcn_s_getreg((3 << 11) | 20) & 0xFu; }
#define XB_SPIN(cond, bar) do { unsigned _sp = 0; while (cond) { __builtin_amdgcn_s_sleep(1); \
    if ((++_sp & 255u) == 0u) { if (xb_ld(&(bar)[XB_TMO])) break; if (_sp > XB_SPIN_CAP) { atomicAdd(&(bar)[XB_TMO], 1u); break; } } } } while (0)

struct XcdBarrier {
    unsigned* bar; unsigned x; unsigned wv;
    volatile LAS unsigned* st;
};

__device__ __forceinline__ XcdBarrier xcd_barrier_post(unsigned* bar, volatile LAS unsigned* st) {
    XcdBarrier b; b.bar = bar; b.x = xb_xcc_id(); b.st = st;
    if (threadIdx.x == 0) (void)xb_add(&bar[XB_XCNT(b.x)], 1u);
    b.wv = (unsigned)__builtin_amdgcn_readfirstlane((int)(threadIdx.x >> 6));
    return b;
}
__device__ __forceinline__ void xcd_barrier_complete(unsigned* bar, unsigned x, unsigned& nloc, unsigned& nx) {
    const unsigned G = gridDim.x * gridDim.y * gridDim.z;
    unsigned sum, cnt, mine, sp = 0u;
    for (;;) {
        sum = 0u; cnt = 0u; mine = 0u;
#pragma unroll
        for (unsigned j = 0; j < 16; ++j) { const unsigned c = xb_ld(&bar[XB_XCNT(j)]); sum += c; cnt += (c > 0u) ? 1u : 0u; mine = (j == x) ? c : mine; }
        if (sum == G) break;
        __builtin_amdgcn_s_sleep(1);
        if ((++sp & 255u) == 0u) { if (xb_ld(&bar[XB_TMO])) break; if (sp > XB_SPIN_CAP) { atomicAdd(&bar[XB_TMO], 1u); break; } }
    }
    nloc = mine > 0u ? mine : 1u; nx = cnt > 0u ? cnt : 1u;
}

__device__ __forceinline__ void xcd_barrier(const XcdBarrier& b) {
    asm volatile("s_waitcnt vmcnt(0)" ::: "memory");
    __syncthreads();
    if (b.wv == 0u && lane_id_v() == 0) {
        unsigned* bar = b.bar;
        __builtin_amdgcn_s_waitcnt(0);
        unsigned nloc = b.st[0], nx = b.st[1];
        if (nloc == 0u) { xcd_barrier_complete(bar, b.x, nloc, nx); b.st[0] = nloc; b.st[1] = nx; }
        const unsigned old = xb_add(&bar[XB_XSUB(b.x)], 1u);
        const unsigned gen = old / nloc;
        if (old + 1u == (gen + 1u) * nloc) {
            __builtin_amdgcn_fence(__ATOMIC_RELEASE, "agent");
            asm volatile("s_waitcnt vmcnt(0)" ::: "memory");
            const unsigned og = xb_add(&bar[XB_TOP], 1u);
            const unsigned tg = og / nx;
            if (og + 1u == (tg + 1u) * nx) xb_add(&bar[XB_TOPGEN], 1u);
            else XB_SPIN(xb_ld(&bar[XB_TOPGEN]) == tg, bar);
            __builtin_amdgcn_fence(__ATOMIC_ACQUIRE, "agent");
            xb_add(&bar[XB_XGEN(b.x)], 1u);
            asm volatile("s_waitcnt vmcnt(0)" ::: "memory");
        } else {
            XB_SPIN(xb_ld(&bar[XB_XGEN(b.x)]) == gen, bar);
            __builtin_amdgcn_fence(__ATOMIC_ACQUIRE, "agent");
            asm volatile("s_waitcnt vmcnt(0)" ::: "memory");
        }
    }
    __syncthreads();
}
struct Frame {
    unsigned char* lds;
    gu32* ctl;
    int wave, G, bid;
    unsigned char* ws; float* out;
    const float *x_p, *x_s, *cache_k, *cache_v, *state, *w_in, *w_gate2, *b_gate, *lq1, *lk1, *lq2, *lk2, *dng, *gng, *w_out, *ln1g, *ln1b, *ln2g, *ln2b, *peer_wq, *keys1, *keys2, *peer_u, *peer_v;
};

template <int MODE>
__device__ __forceinline__ void p0_transpose_item(const float* W, int K, int N, bf16* WT, float* scr, int kb, int nb, int lane) {
    const int k0 = 64 * kb, n0 = 64 * nb; const int nc = n0 + lane; const bool okc = nc < N;
    float v[64];
#pragma unroll
    for (int i = 0; i < 64; ++i) v[i] = okc ? W[(size_t)(k0 + i) * N + nc] : 0.f;
#pragma unroll
    for (int i = 0; i < 64; ++i) scr[i * 65 + lane] = v[i];
    LDS_WAIT(); asm volatile("" ::: "memory");
    const int c = lane & 7;
#pragma unroll
    for (int j = 0; j < 8; ++j) { const int n = (lane >> 3) + 8 * j; const float* s = scr + (8 * c) * 65 + n; const int gn = n0 + n;
        v4u o; o.x = pk2(s[0 * 65], s[1 * 65]); o.y = pk2(s[2 * 65], s[3 * 65]); o.z = pk2(s[4 * 65], s[5 * 65]); o.w = pk2(s[6 * 65], s[7 * 65]);
        int dr = gn;
        if (MODE == 1 && gn < 4096) { const int jj = gn & 127; dr = (gn & ~127) + (jj < 64 ? 2 * jj : 2 * (jj - 64) + 1); }
        if (gn < N) *(v4u*)(WT + (size_t)dr * K + k0 + 8 * c) = o; }
    LDS_WAIT(); asm volatile("" ::: "memory");
}
__device__ __forceinline__ void cvt8(const float* src, bf16* dst) {
    const f32x4 a = *(const f32x4*)src, b = *(const f32x4*)(src + 4);
    v4u o; o.x = pk2(a[0], a[1]); o.y = pk2(a[2], a[3]); o.z = pk2(b[0], b[1]); o.w = pk2(b[2], b[3]);
    *(v4u*)dst = o;
}
__device__ __forceinline__ void cvt_stream(const float* src, bf16* dst, size_t n8, size_t gt, size_t ngt) {
    size_t i = gt;
    for (; i + 3 * ngt < n8; i += 4 * ngt) {
        f32x4 a[4], b[4];
#pragma unroll
        for (int k = 0; k < 4; ++k) { a[k] = *(const f32x4*)(src + (i + k * ngt) * 8); b[k] = *(const f32x4*)(src + (i + k * ngt) * 8 + 4); }
#pragma unroll
        for (int k = 0; k < 4; ++k) { v4u o; o.x = pk2(a[k][0], a[k][1]); o.y = pk2(a[k][2], a[k][3]); o.z = pk2(b[k][0], b[k][1]); o.w = pk2(b[k][2], b[k][3]); *(v4u*)(dst + (i + k * ngt) * 8) = o; }
    }
    for (; i < n8; i += ngt) cvt8(src + i * 8, dst + i * 8);
}
__device__ __forceinline__ void cvt_cache_unit(Frame& F, int u) {
    bf16* KSB = (bf16*)(F.ws + WS_H); bf16* VSB = (bf16*)(F.ws + WS_H + 72 * MiB); const int tid = F.wave * 64 + lane_id_v();
    if (u < 128) { const int sb = u >> 3, r0 = 128 * (u & 7);
        const float* ck = F.cache_k + ((size_t)sb * 1024 + r0) * 2048; const float* cv = F.cache_v + ((size_t)sb * 1024 + r0) * 2048; const size_t d0 = ((size_t)sb * 1152 + r0) * 2048;
        for (int k = tid; k < 128 * 256; k += 512) { cvt8(ck + (size_t)k * 8, KSB + d0 + (size_t)k * 8); cvt8(cv + (size_t)k * 8, VSB + d0 + (size_t)k * 8); } }
    else { const int sb = u - 128; const size_t d0 = ((size_t)sb * 1152 + 1040) * 2048;
        for (int k = tid; k < 112 * 256; k += 512) { *(v4u*)(KSB + d0 + (size_t)k * 8) = (v4u){0u, 0u, 0u, 0u}; *(v4u*)(VSB + d0 + (size_t)k * 8) = (v4u){0u, 0u, 0u, 0u}; } }
}
__device__ __forceinline__ void cvt_cache_drain(Frame& F, int max_units) {
    volatile unsigned* slot = (volatile unsigned*)(F.lds + MISC_OFF + 64);
    for (int n = 0; n < max_units; ++n) {
        __syncthreads();
        if ((F.wave * 64 + lane_id_v()) == 0) *slot = __hip_atomic_fetch_add((unsigned*)(F.ctl + CW_QUEUE + 64 * 9), 1u, __ATOMIC_RELAXED, __HIP_MEMORY_SCOPE_AGENT);
        __syncthreads();
        const int u = __builtin_amdgcn_readfirstlane((int)*slot);
        if (u >= 144) break;
        cvt_cache_unit(F, u);
    }
}
__device__ __forceinline__ void p0_prologue(Frame& F) {
    float* scr = (float*)(F.lds + F.wave * 16640);
    const int gw = F.bid * NWAVES + F.wave, NGW = F.G * NWAVES;
    const size_t gt = (size_t)F.bid * 512 + (F.wave * 64 + lane_id_v()), ngt = (size_t)F.G * 512;
    bf16* XB = (bf16*)(F.ws + WS_A); bf16* WIN_T = (bf16*)(F.ws + WS_B); bf16* WOUT_T = (bf16*)(F.ws + WS_WOUT); bf16* WQ_T = (bf16*)(F.ws + WS_WQ);
    constexpr int I_IN = 64 * 193, I_OUT = 64 * 64, I_Q = 64 * 32;
    for (int it = gw; it < I_IN + I_OUT + I_Q; it += NGW) {
        int r = it;
        if (r < I_IN) { p0_transpose_item<1>(F.w_in, DM, NPROJ, WIN_T, scr, r / 193, r % 193, lane_id_v()); continue; } r -= I_IN;
        if (r < I_OUT) { p0_transpose_item<0>(F.w_out, DM, DM, WOUT_T, scr, r / 64, r % 64, lane_id_v()); continue; } r -= I_OUT;
        p0_transpose_item<0>(F.peer_wq, DM, 2048, WQ_T, scr, r / 32, r % 32, lane_id_v());
    }
    { const size_t n16 = (size_t)(NPROJ_PAD - NPROJ) * DM * 2 / 16; v4u* z = (v4u*)(WIN_T + (size_t)NPROJ * DM);
      for (size_t i = gt; i < n16; i += ngt) z[i] = (v4u){0u, 0u, 0u, 0u}; }
    cvt_stream(F.x_p, XB, (size_t)TP * DM / 8, gt, ngt);
    cvt_stream(F.x_s, XB + (size_t)TP * DM, (size_t)TSM * DM / 8, gt, ngt);
    cvt_stream(F.keys1, (bf16*)(F.ws + WS_KEYB), (size_t)8 * 128 * 128 / 8, gt, ngt);
    cvt_stream(F.keys2, (bf16*)(F.ws + WS_KEYB) + 8 * 128 * 128, (size_t)8 * 128 * 128 / 8, gt, ngt);
    { float* rope = (float*)(F.ws + WS_ROPE);
      for (size_t idx = gt; idx < (size_t)8192 * 64; idx += ngt) {
          const int pos = (int)(idx >> 6), i = (int)(idx & 63);
          double inv = 1.0;
          if (i & 1) inv *= 0.8659643233600653; if (i & 2) inv *= 0.7498942093324558; if (i & 4) inv *= 0.5623413251903491;
          if (i & 8) inv *= 0.31622776601683794; if (i & 16) inv *= 0.09999999999999999; if (i & 32) inv *= 0.009999999999999998;
          const float invf = (float)inv; const float angf = (float)pos * invf; const double a = (double)angf;
          const double n = __builtin_rint(a * 0.15915494309189535); const double rr = __builtin_fma(-n, 6.283185307179586, a);
          const double kq = __builtin_rint(rr * 0.6366197723675814); const double y = __builtin_fma(-kq, 1.5707963267948966, rr); const double y2 = y * y;
          double s = 1.0 / 6227020800.0;
          s = s * y2 - 1.0 / 39916800.0; s = s * y2 + 1.0 / 362880.0; s = s * y2 - 1.0 / 5040.0; s = s * y2 + 1.0 / 120.0; s = s * y2 - 1.0 / 6.0; s = s * y2 + 1.0; s = s * y;
          double c = -1.0 / 87178291200.0;
          c = c * y2 + 1.0 / 479001600.0; c = c * y2 - 1.0 / 3628800.0; c = c * y2 + 1.0 / 40320.0; c = c * y2 - 1.0 / 720.0; c = c * y2 + 1.0 / 24.0; c = c * y2 - 0.5; c = c * y2 + 1.0;
          const int q = ((int)kq) & 3; double cs, sn;
          if (q == 0) { sn = s; cs = c; } else if (q == 1) { sn = c; cs = -s; } else if (q == 2) { sn = -s; cs = -c; } else { sn = -c; cs = s; }
          rope[idx * 2] = (float)cs; rope[idx * 2 + 1] = (float)sn;
      } }
}
__device__ __forceinline__ float log_sigmoid_f(float z) { return fminf(z, 0.f) - __logf(1.f + __expf(-fabsf(z))); }
__device__ __forceinline__ int qin_slot(int ch) { const int c = ch & 15; return (ch & ~15) + ((c >= 4 && c < 12) ? (c ^ 12) : c); }
__device__ __forceinline__ void gla_prep_prompt(Frame& F, int item) {
    const int c = item & 127, h = (item >> 7) & 3, b = item >> 9; const int m0 = b * SEQ + 64 * c;
    float* bc = (float*)F.lds;
    bf16* qs = (bf16*)(F.lds + 65536);
    bf16* ks = (bf16*)(F.lds + 65536 + 33792);
    float* gzs = (float*)(F.lds + 65536 + 2 * 33792);
    const float* GZ = (const float*)(F.ws + WS_GZ);
    const bf16* GQ = (const bf16*)(F.ws + WS_D); const bf16* GK = (const bf16*)(F.ws + WS_D + SZ_TOK2048 / 2); const bf16* GV = (const bf16*)(F.ws + WS_D + SZ_TOK2048);
    bf16* QIN = (bf16*)(F.ws + WS_QIN) + (size_t)item * 64 * 256; bf16* KENDT = (bf16*)(F.ws + WS_KENDT) + (size_t)item * 256 * 64;
    bf16* AM = (bf16*)(F.ws + WS_AM) + (size_t)item * 4096; float* DEC = (float*)(F.ws + WS_DEC) + (size_t)item * 256; bf16* VT = (bf16*)(F.ws + WS_E) + (size_t)item * 512 * 64;
    const int t = (F.wave * 64 + lane_id_v()), ch = t & 255, th = t >> 8;
    v4u vpre[8];
#pragma unroll
    for (int i = 0; i < 8; ++i) { const int p = t + 512 * i, tok = p >> 6, c8 = p & 63; vpre[i] = *(const v4u*)(GV + (size_t)(m0 + tok) * 2048 + h * 512 + 8 * c8); }
    unsigned short qa[32], ka[32];
#pragma unroll
    for (int e = 0; e < 32; ++e) { const int tok = 32 * th + e; qa[e] = GQ[(size_t)(m0 + tok) * 1024 + h * 256 + ch]; ka[e] = GK[(size_t)(m0 + tok) * 1024 + h * 256 + ch]; }
    const float gz0 = GZ[(size_t)(m0 + (t >> 4)) * 16 + (t & 15)], gz1 = GZ[(size_t)(m0 + 32 + (t >> 4)) * 16 + (t & 15)];
    __syncthreads();
    gzs[t] = gz0; gzs[t + 512] = gz1;
    float wg[16];
#pragma unroll
    for (int k = 0; k < 16; ++k) wg[k] = F.w_gate2[k * 1024 + h * 256 + ch];
    const float bias = F.b_gate[h * 256 + ch];
    __syncthreads();
    float run = 0.f;
    for (int tt = 0; tt < 32; ++tt) { const int tok = 32 * th + tt; float z = bias;
        const f32x4 z0 = *(const f32x4*)(gzs + tok * 16), z1 = *(const f32x4*)(gzs + tok * 16 + 4), z2 = *(const f32x4*)(gzs + tok * 16 + 8), z3 = *(const f32x4*)(gzs + tok * 16 + 12);
#pragma unroll
        for (int k = 0; k < 4; ++k) { z = fmaf(z0[k], wg[k], z); z = fmaf(z1[k], wg[4 + k], z); z = fmaf(z2[k], wg[8 + k], z); z = fmaf(z3[k], wg[12 + k], z); }
        run += log_sigmoid_f(z) * 0.0625f; bc[tok * 256 + ch] = run; }
    __syncthreads();
    const float b31 = bc[31 * 256 + ch]; const float btot = b31 + bc[63 * 256 + ch]; const float offs = th ? b31 : 0.f;
#pragma unroll
    for (int j4 = 0; j4 < 4; ++j4) {
        unsigned short qv[8], kv[8];
#pragma unroll
        for (int e = 0; e < 8; ++e) { qv[e] = qa[8 * j4 + e]; kv[e] = ka[8 * j4 + e]; }
        unsigned kp[4];
#pragma unroll
        for (int e2 = 0; e2 < 4; ++e2) {
            float ke[2];
#pragma unroll
            for (int e = 0; e < 2; ++e) { const int tok = 32 * th + 8 * j4 + 2 * e2 + e; const float bb = bc[tok * 256 + ch] + offs;
                const float q = bf2f(qv[2 * e2 + e]), k = bf2f(kv[2 * e2 + e]);
                const float qin = q * __expf(bb) * 0.0625f, kin = k * __expf(-bb); ke[e] = k * __expf(btot - bb);
                const unsigned short qb = (unsigned short)f2bf(qin);
                qs[tok * 264 + ch] = qb; ks[tok * 264 + ch] = (unsigned short)f2bf(kin);
                { const int sl = qin_slot(ch); QIN[tok * 256 + ((((sl >> 3) ^ (tok & 31)) << 3) | (sl & 7))] = qb; } }
            kp[e2] = pk2(ke[0], ke[1]);
        }
        *(v4u*)(KENDT + ch * 64 + (((4 * th + j4) ^ ((ch >> 1) & 7)) << 3)) = (v4u){kp[0], kp[1], kp[2], kp[3]};
    }
    if (th == 0) DEC[ch] = __expf(btot);
    __syncthreads();
    if (F.wave < 4) {
        const int tt = F.wave >> 1, ss = F.wave & 1, r32 = lane_id_v() & 31, hi = lane_id_v() >> 5;
        f32x16 d = {};
        if (!(tt == 0 && ss == 1)) {
#pragma unroll
            for (int kk = 0; kk < 16; ++kk) {
                const bf16x8 a = *(const bf16x8*)(qs + (32 * tt + r32) * 264 + 16 * kk + 8 * hi);
                const bf16x8 bq = *(const bf16x8*)(ks + (32 * ss + r32) * 264 + 16 * kk + 8 * hi);
                d = MFMA32(a, bq, d);
            }
        }
#pragma unroll
        for (int r = 0; r < 16; ++r) { const int ta = 32 * tt + crow(r, hi), sa = 32 * ss + r32; AM[ta * 64 + ((((sa >> 3) ^ ((ta >> 1) & 7)) << 3) | (sa & 7))] = (unsigned short)f2bf(sa <= ta ? d[r] : 0.f); }
    }
    __syncthreads();
    bf16* vs = (bf16*)F.lds;
#pragma unroll
    for (int i = 0; i < 8; ++i) { const int p = t + 512 * i, tok = p >> 6, c8 = p & 63; *(v4u*)(vs + tok * 520 + 8 * c8) = vpre[i]; }
    __syncthreads();
    { const int dv = t;
#pragma unroll
      for (int g = 0; g < 8; ++g) { unsigned w[4];
#pragma unroll
          for (int j = 0; j < 4; ++j) w[j] = (unsigned)vs[(8 * g + 2 * j) * 520 + dv] | ((unsigned)vs[(8 * g + 2 * j + 1) * 520 + dv] << 16);
          *(v4u*)(VT + dv * 64 + 8 * g) = (v4u){w[0], w[1], w[2], w[3]}; } }
}
__device__ __forceinline__ void sample_kv_copy(Frame& F, int item) {
    const int h = item & 3, sb = item >> 2; const int m0 = TP + sb * 16; const int t = (F.wave * 64 + lane_id_v());
    { const bf16* KB = (const bf16*)(F.ws + WS_C + SZ_TOK2048); const bf16* VB = (const bf16*)(F.ws + WS_C + 2 * SZ_TOK2048);
      bf16* KSB = (bf16*)(F.ws + WS_H); bf16* VSB = (bf16*)(F.ws + WS_H + 72 * MiB);
      const int row = t >> 5, pc = t & 31;
#pragma unroll
      for (int hh = 0; hh < 2; ++hh) { const size_t src = (size_t)(m0 + row) * 2048 + (h + 4 * hh) * 256 + 8 * pc, dst = ((size_t)sb * 1152 + 1024 + row) * 2048 + (h + 4 * hh) * 256 + 8 * pc;
          *(v4u*)(KSB + dst) = *(const v4u*)(KB + src); *(v4u*)(VSB + dst) = *(const v4u*)(VB + src); } }
}
__device__ __forceinline__ void gla_sample_item(Frame& F, int item) {
    const int h = item & 3, sb = item >> 2; const int m0 = TP + sb * 16;
    float* qT = (float*)F.lds;
    float* kT = qT + 4096;
    float* kin = kT + 4096;
    float* qn = kin + 4096;
    float* Am = qn + 4096;
    float* dec = Am + 256;
    float* gzs = dec + 256;
    const float* GZ = (const float*)(F.ws + WS_GZ);
    const bf16* GQ = (const bf16*)(F.ws + WS_D); const bf16* GK = (const bf16*)(F.ws + WS_D + SZ_TOK2048 / 2); const bf16* GV = (const bf16*)(F.ws + WS_D + SZ_TOK2048);
    bf16* MIXIN = (bf16*)(F.ws + WS_F);
    const int t = (F.wave * 64 + lane_id_v());
    __syncthreads();
    if (t < 256) gzs[t] = GZ[(size_t)(m0 + (t >> 4)) * 16 + (t & 15)];
    __syncthreads();
    if (t < 256) {
        const int ch = t; float wg[16];
#pragma unroll
        for (int k = 0; k < 16; ++k) wg[k] = F.w_gate2[k * 1024 + h * 256 + ch];
        const float bias = F.b_gate[h * 256 + ch];
        float bb[16]; float run = 0.f;
#pragma unroll
        for (int tok = 0; tok < 16; ++tok) { float z = bias;
#pragma unroll
            for (int k = 0; k < 16; ++k) z = fmaf(gzs[tok * 16 + k], wg[k], z);
            run += log_sigmoid_f(z) * 0.0625f; bb[tok] = run; }
        const float btot = run;
#pragma unroll
        for (int tok = 0; tok < 16; ++tok) {
            const float q = bf2f(GQ[(size_t)(m0 + tok) * 1024 + h * 256 + ch]), k = bf2f(GK[(size_t)(m0 + tok) * 1024 + h * 256 + ch]);
            const float qi = q * __expf(bb[tok]) * 0.0625f;
            qT[ch * 16 + tok] = qi; qn[tok * 256 + ch] = qi; kin[tok * 256 + ch] = k * __expf(-bb[tok]); kT[ch * 16 + tok] = k * __expf(btot - bb[tok]); }
        dec[ch] = __expf(btot);
    }
    __syncthreads();
    if (t < 256) { const int ti = t >> 4, si = t & 15; float a = 0.f;
        if (si <= ti) { for (int chh = 0; chh < 256; ++chh) a = fmaf(qn[ti * 256 + chh], kin[si * 256 + chh], a); }
        Am[ti * 16 + si] = a; }
    __syncthreads();
    { const int dv = t; float v[16], o[16];
#pragma unroll
      for (int s = 0; s < 16; ++s) v[s] = bf2f(GV[(size_t)(m0 + s) * 2048 + h * 512 + dv]);
#pragma unroll
      for (int ti = 0; ti < 16; ++ti) { float a = 0.f;
#pragma unroll
          for (int s = 0; s < 16; ++s) a = fmaf(Am[ti * 16 + s], v[s], a);
          o[ti] = a; }
      const float* S0 = F.state + ((size_t)(sb * 4 + h) * 256) * 512 + dv; float* S1 = F.out + O_GS + ((size_t)(sb * 4 + h) * 256) * 512 + dv;
      for (int chh = 0; chh < 256; ++chh) {
          const float s0 = S0[(size_t)chh * 512];
          const f32x4* qp = (const f32x4*)(qT + chh * 16); const f32x4* kp = (const f32x4*)(kT + chh * 16);
          float sn = dec[chh] * s0;
#pragma unroll
          for (int j = 0; j < 4; ++j) { const f32x4 qv = qp[j], kv = kp[j];
#pragma unroll
              for (int e = 0; e < 4; ++e) { o[4 * j + e] = fmaf(qv[e], s0, o[4 * j + e]); sn = fmaf(kv[e], v[4 * j + e], sn); } }
          S1[(size_t)chh * 512] = sn;
      }
#pragma unroll
      for (int ti = 0; ti < 16; ++ti) MIXIN[(size_t)(m0 + ti) * 4096 + 2048 + h * 512 + dv] = (unsigned short)f2bf(o[ti]);
    }
}
__device__ __forceinline__ void p2_gla_prep(Frame& F) {
    for (int it = F.bid; it < 1024 + 64; it += F.G) { if (it < 1024) gla_prep_prompt(F, it); else sample_kv_copy(F, it - 1024); }
}
namespace att {
constexpr int D = 128, NW = 8, QBLK = 32, KVBLK = 64;
constexpr float SCALE = 0.088388347648318440f, THR = 8.f;
constexpr int LDQ = 2048, LDK = 2048, LDO = 1024;
constexpr size_t SHM_V = KVBLK * D * 2, SHM_K = KVBLK * D * 2, SHM_ATTN = 2 * SHM_V + 2 * SHM_K + NW * 64 * 4;
#define KSWZ(row, colB) ((row) * 256 + ((colB) ^ (((row) & 7) << 4)))
#define SBAR() __builtin_amdgcn_sched_barrier(0)
__device__ __forceinline__ unsigned cvtpk(float lo, float hi) { unsigned r; asm volatile("v_cvt_pk_bf16_f32 %0, %1, %2" : "=v"(r) : "v"(lo), "v"(hi)); return r; }
__device__ __forceinline__ void partialSM(f32x16& p0, f32x16& p1, float& m_reg, float& mn, float& alpha, int rem, int hi) {
  constexpr float C = SCALE * 1.4426950408889634f;
  if (rem < 64) {
#pragma unroll
    for (int r = 0; r < 16; ++r) { if (8 * (r >> 2) >= rem) p0[r] = -1e30f; if (32 + 8 * (r >> 2) >= rem) p1[r] = -1e30f; }
  }
  float pmax = p0[0];
#pragma unroll
  for (int r = 1; r < 16; ++r) pmax = fmaxf(pmax, p0[r]);
#pragma unroll
  for (int r = 0; r < 16; ++r) pmax = fmaxf(pmax, p1[r]);
  { auto rr = __builtin_amdgcn_permlane32_swap(__float_as_uint(pmax), __float_as_uint(pmax), false, false);
    pmax = fmaxf(__uint_as_float(rr[0]), __uint_as_float(rr[1])); }
  if (__builtin_expect(__all(pmax - m_reg <= THR / SCALE), 1)) { mn = m_reg; alpha = 1.f; }
  else { mn = fmaxf(m_reg, pmax); alpha = __builtin_amdgcn_exp2f((m_reg - mn) * C); m_reg = mn; }
  float mnC = -mn * C;
#pragma unroll
  for (int r = 0; r < 16; ++r) p0[r] = fmaf(p0[r], C, mnC);
#pragma unroll
  for (int r = 0; r < 16; ++r) p1[r] = fmaf(p1[r], C, mnC);
#pragma unroll
  for (int r = 0; r < 16; ++r) p0[r] = __builtin_amdgcn_exp2f(p0[r]);
}
__device__ __forceinline__ void finishSM(f32x16& p0, f32x16& p1, float alpha, float& l_reg, bf16x8& pa0, bf16x8& pa1, bf16x8& pa2, bf16x8& pa3) {
#pragma unroll
  for (int r = 0; r < 16; ++r) p1[r] = __builtin_amdgcn_exp2f(p1[r]);
  float ps = 0;
#pragma unroll
  for (int r = 0; r < 16; ++r) ps += p0[r];
#pragma unroll
  for (int r = 0; r < 16; ++r) ps += p1[r];
  { auto rr = __builtin_amdgcn_permlane32_swap(__float_as_uint(ps), __float_as_uint(ps), false, false);
    ps = __uint_as_float(rr[0]) + __uint_as_float(rr[1]); }
  l_reg = l_reg * alpha + ps;
#define PK4(P, BASE, OUT) do { unsigned a0 = cvtpk(P[BASE + 0], P[BASE + 1]), a1 = cvtpk(P[BASE + 2], P[BASE + 3]);   \
    unsigned b0 = cvtpk(P[BASE + 4], P[BASE + 5]), b1 = cvtpk(P[BASE + 6], P[BASE + 7]);                              \
    auto r0 = __builtin_amdgcn_permlane32_swap(a0, b0, false, false); auto r1 = __builtin_amdgcn_permlane32_swap(a1, b1, false, false); \
    v4u w = {r0[0], r1[0], r0[1], r1[1]}; OUT = *reinterpret_cast<bf16x8*>(&w); } while (0)
  PK4(p0, 0, pa0); PK4(p0, 8, pa1); PK4(p1, 0, pa2); PK4(p1, 8, pa3);
#undef PK4
}
__device__ __forceinline__ void qkt(f32x16& p0, f32x16& p1, const bf16* Ks, const bf16x8* qr, int r32, int hi) {
  p0 = f32x16{}; p1 = f32x16{};
#pragma unroll
  for (int d0 = 0; d0 < 8; ++d0) { int cb = (d0 * 16 + hi * 8) * 2;
    bf16x8 b0 = *reinterpret_cast<const bf16x8*>((const char*)Ks + KSWZ(r32, cb));
    bf16x8 b1 = *reinterpret_cast<const bf16x8*>((const char*)Ks + KSWZ(32 + r32, cb));
    p0 = __builtin_amdgcn_mfma_f32_32x32x16_bf16(b0, qr[d0], p0, 0, 0, 0);
    p1 = __builtin_amdgcn_mfma_f32_32x32x16_bf16(b1, qr[d0], p1, 0, 0, 0); }
}
__device__ __forceinline__ int v_st(int k, int c) { const int kk = (k & ~0xC) | ((k & 4) << 1) | ((k & 8) >> 1); return ((kk >> 3) * 4 + (c >> 5)) * 512 + ((kk & 7) * 32 + (c & 31)) * 2; }
__device__ __forceinline__ int v_rd_base(int lane) { return ((lane & 3) << 3) | (((lane >> 2) & 3) << 6) | (((lane >> 4) & 1) << 5) | (((lane >> 5) & 1) << 8); }
constexpr int v_rd_off(int d0, int ks, int half) { return d0 * 512 + ks * 4096 + half * 2048; }
template <int OFF> __device__ __forceinline__ s16x4 tr_read(int vb) {
  s16x4 r; asm volatile("ds_read_b64_tr_b16 %0, %1 offset:%2" : "=&v"(r) : "v"(vb), "i"(OFF) : "memory"); return r;
}
template <int D0> __device__ __forceinline__ void pv_one(f32x16& od, int vb, bf16x8 pa0, bf16x8 pa1, bf16x8 pa2, bf16x8 pa3) {
  const s16x4 l0 = tr_read<v_rd_off(D0, 0, 0)>(vb), h0 = tr_read<v_rd_off(D0, 0, 1)>(vb), l1 = tr_read<v_rd_off(D0, 1, 0)>(vb), h1 = tr_read<v_rd_off(D0, 1, 1)>(vb);
  const s16x4 l2 = tr_read<v_rd_off(D0, 2, 0)>(vb), h2 = tr_read<v_rd_off(D0, 2, 1)>(vb), l3 = tr_read<v_rd_off(D0, 3, 0)>(vb), h3 = tr_read<v_rd_off(D0, 3, 1)>(vb);
  asm volatile("s_waitcnt lgkmcnt(0)" ::: "memory"); SBAR();
#define PK(L, H) (bf16x8){L[0], L[1], L[2], L[3], H[0], H[1], H[2], H[3]}
  od = __builtin_amdgcn_mfma_f32_32x32x16_bf16(pa0, PK(l0, h0), od, 0, 0, 0);
  od = __builtin_amdgcn_mfma_f32_32x32x16_bf16(pa1, PK(l1, h1), od, 0, 0, 0);
  od = __builtin_amdgcn_mfma_f32_32x32x16_bf16(pa2, PK(l2, h2), od, 0, 0, 0);
  od = __builtin_amdgcn_mfma_f32_32x32x16_bf16(pa3, PK(l3, h3), od, 0, 0, 0);
#undef PK
}
__device__ __forceinline__ void pv_d0(f32x16* o, int vb, bf16x8 pa0, bf16x8 pa1, bf16x8 pa2, bf16x8 pa3) {
  pv_one<0>(o[0], vb, pa0, pa1, pa2, pa3); pv_one<1>(o[1], vb, pa0, pa1, pa2, pa3); pv_one<2>(o[2], vb, pa0, pa1, pa2, pa3); pv_one<3>(o[3], vb, pa0, pa1, pa2, pa3);
}
__device__ __forceinline__ void attn_body(const bf16* __restrict__ Qb, int nq, const bf16* __restrict__ Kh, const bf16* __restrict__ Vh, int kvalid, int NT, float* __restrict__ Ob, char* lds) {
  int tid_ = threadIdx.x; asm volatile("" : "+v"(tid_));
  const int tid = tid_, wid = __builtin_amdgcn_readfirstlane(tid >> 6), lane = tid & 63, r32 = lane & 31, hi = lane >> 5;
  bf16* V_lds = (bf16*)lds; bf16* K_lds = (bf16*)(lds + 2 * SHM_V);
  float* ws = (float*)(lds + 2 * SHM_V + 2 * SHM_K) + wid * 64; float* li_l = ws; float* al_l = ws + 32;
  float m_reg = -1e30f, l_reg = 0; f32x16 o[4] = {}; bf16x8 qr[8];
  { const bf16* Qw = Qb + (long)(wid * QBLK + r32) * LDQ + hi * 8;
#pragma unroll
    for (int d0 = 0; d0 < 8; ++d0) qr[d0] = *reinterpret_cast<const bf16x8*>(Qw + d0 * 16); }
  const int sr = tid >> 4, sc = (tid & 15) * 8, vst0 = v_st(sr, sc), vst1 = v_st(32 + sr, sc);
  const int vb0 = (int)(uintptr_t)V_lds + v_rd_base(lane);
  struct { bf16x8 vs0, vs1, ks0, ks1; } sr_[2];
#define SLOAD(i, k0) do { sr_[i].vs0 = *reinterpret_cast<const bf16x8*>(&Vh[(long)((k0) + sr) * LDK + sc]); sr_[i].vs1 = *reinterpret_cast<const bf16x8*>(&Vh[(long)((k0) + 32 + sr) * LDK + sc]); \
    sr_[i].ks0 = *reinterpret_cast<const bf16x8*>(&Kh[(long)((k0) + sr) * LDK + sc]); sr_[i].ks1 = *reinterpret_cast<const bf16x8*>(&Kh[(long)((k0) + 32 + sr) * LDK + sc]); } while (0)
#define SWRITE(b, i) do { *(bf16x8*)((char*)V_lds + (b) * SHM_V + vst0) = sr_[i].vs0;          \
    *(bf16x8*)((char*)V_lds + (b) * SHM_V + vst1) = sr_[i].vs1; int kc = sc * 2;               \
    *(bf16x8*)((char*)K_lds + (b) * SHM_K + KSWZ(sr, kc)) = sr_[i].ks0;                       \
    *(bf16x8*)((char*)K_lds + (b) * SHM_K + KSWZ(32 + sr, kc)) = sr_[i].ks1; } while (0)
#define SWAIT() asm volatile("s_waitcnt vmcnt(4)" ::: "memory")
#define RESC(a) do { if (__any((a) < 1.f)) { if (hi == 0) al_l[r32] = (a); asm volatile("s_waitcnt lgkmcnt(0)" ::: "memory"); \
    _Pragma("unroll") for (int d = 0; d < 4; ++d) _Pragma("unroll") for (int r = 0; r < 16; ++r) o[d][r] *= al_l[crow(r, hi)]; } } while (0)
  f32x16 pA0, pA1, pB0, pB1; float mnA, mnB, alA, alB; bf16x8 pa0, pa1, pa2, pa3;
  constexpr int SE = 0, SO = 1;
  SLOAD(SE, 0); asm volatile("s_waitcnt vmcnt(0)" ::: "memory"); SWRITE(0, SE); __syncthreads();
  qkt(pA0, pA1, K_lds, qr, r32, hi); partialSM(pA0, pA1, m_reg, mnA, alA, kvalid, hi);
  SLOAD(SO, KVBLK); if (2 < NT) SLOAD(SE, 2 * KVBLK);
  SWAIT(); SWRITE(1, SO); __syncthreads();
  for (int j = 1; j + 1 < NT; j += 2) {
    SBAR(); qkt(pB0, pB1, (bf16*)((char*)K_lds + SHM_K), qr, r32, hi);
    finishSM(pA0, pA1, alA, l_reg, pa0, pa1, pa2, pa3); SBAR();
    SLOAD(SO, (j + 2) * KVBLK); SBAR();
    pv_d0(o, vb0, pa0, pa1, pa2, pa3); partialSM(pB0, pB1, m_reg, mnB, alB, kvalid - 64 * j, hi);
    __syncthreads(); SWAIT(); SWRITE(0, SE);
    RESC(alB); __syncthreads();
    SBAR(); qkt(pA0, pA1, K_lds, qr, r32, hi);
    finishSM(pB0, pB1, alB, l_reg, pa0, pa1, pa2, pa3); SBAR();
    if (j + 3 < NT) SLOAD(SE, (j + 3) * KVBLK); SBAR();
    pv_d0(o, vb0 + (int)SHM_V, pa0, pa1, pa2, pa3); partialSM(pA0, pA1, m_reg, mnA, alA, kvalid - 64 * (j + 1), hi);
    __syncthreads(); SWAIT(); SWRITE(1, SO);
    RESC(alA); __syncthreads();
  }
  SBAR(); qkt(pB0, pB1, (bf16*)((char*)K_lds + SHM_K), qr, r32, hi);
  finishSM(pA0, pA1, alA, l_reg, pa0, pa1, pa2, pa3); SBAR();
  pv_d0(o, vb0, pa0, pa1, pa2, pa3); partialSM(pB0, pB1, m_reg, mnB, alB, kvalid - 64 * (NT - 1), hi);
  __syncthreads(); RESC(alB);
  finishSM(pB0, pB1, alB, l_reg, pa0, pa1, pa2, pa3); SBAR();
  pv_d0(o, vb0 + (int)SHM_V, pa0, pa1, pa2, pa3);
  if (hi == 0) li_l[r32] = l_reg; asm volatile("s_waitcnt lgkmcnt(0)" ::: "memory");
  float rli[16];
#pragma unroll
  for (int r = 0; r < 16; ++r) rli[r] = __builtin_amdgcn_rcpf(li_l[crow(r, hi)]);
  float* Ow = Ob + (long)(wid * QBLK) * LDO;
#pragma unroll
  for (int r = 0; r < 16; ++r) { int orow = crow(r, hi);
    if (wid * QBLK + orow < nq) {
#pragma unroll
      for (int d0 = 0; d0 < 4; ++d0) Ow[(long)orow * LDO + d0 * 32 + r32] = o[d0][r] * rli[r]; } }
  __syncthreads();
#undef SLOAD
#undef SWRITE
#undef SWAIT
#undef RESC
}
}
namespace dat {
using namespace att;
__device__ __forceinline__ unsigned src_off(int p, int L) {
    const int reg = p >> 4, pp = p & 15; const int o = pp * 1024 + L * 16;
    if (reg < 2) { const int r = o >> 8, cc = (o >> 4) & 15; const int c = cc ^ (r & 7); return (unsigned)(r * LDK + reg * 128 + c * 8) * 2u; }
    const int st = o >> 9, w = o & 511; const int kk = ((st >> 2) << 3) | (w >> 6); const int c = ((st & 3) << 5) | ((w & 63) >> 1);
    const int k = (kk & ~0xC) | ((kk & 4) << 1) | ((kk & 8) >> 1);
    return (unsigned)(k * LDK + (reg - 2) * 128 + c) * 2u;
}
template <int D0> __device__ __forceinline__ void pv_one8(f32x16& od, int vb, bf16x8 pa0, bf16x8 pa1, bf16x8 pa2, bf16x8 pa3) {
  constexpr int HB = (D0 >> 2) * 16384, DD = D0 & 3;
  const s16x4 l0 = tr_read<HB + v_rd_off(DD, 0, 0)>(vb), h0 = tr_read<HB + v_rd_off(DD, 0, 1)>(vb), l1 = tr_read<HB + v_rd_off(DD, 1, 0)>(vb), h1 = tr_read<HB + v_rd_off(DD, 1, 1)>(vb);
  const s16x4 l2 = tr_read<HB + v_rd_off(DD, 2, 0)>(vb), h2 = tr_read<HB + v_rd_off(DD, 2, 1)>(vb), l3 = tr_read<HB + v_rd_off(DD, 3, 0)>(vb), h3 = tr_read<HB + v_rd_off(DD, 3, 1)>(vb);
  asm volatile("s_waitcnt lgkmcnt(0)" ::: "memory"); SBAR();
#define PK(L, H) (bf16x8){L[0], L[1], L[2], L[3], H[0], H[1], H[2], H[3]}
  od = __builtin_amdgcn_mfma_f32_32x32x16_bf16(pa0, PK(l0, h0), od, 0, 0, 0);
  od = __builtin_amdgcn_mfma_f32_32x32x16_bf16(pa1, PK(l1, h1), od, 0, 0, 0);
  od = __builtin_amdgcn_mfma_f32_32x32x16_bf16(pa2, PK(l2, h2), od, 0, 0, 0);
  od = __builtin_amdgcn_mfma_f32_32x32x16_bf16(pa3, PK(l3, h3), od, 0, 0, 0);
#undef PK
}
__device__ __forceinline__ void dattn_unit(const bf16* __restrict__ Qb, const bf16* __restrict__ Kh, const bf16* __restrict__ Vh, int nq, int kv_lo, int kv_hi, int NT,
                                           bf16* __restrict__ outp, const float* __restrict__ gnorm, float lam, unsigned char* lds, int tid_in) {
  const int tid_ = tid_in;
  const int tid = tid_, wid = __builtin_amdgcn_readfirstlane(tid >> 6), lane = tid & 63, r32 = lane & 31, hi = lane >> 5;
  const int br = wid >> 2, rg = wid & 3;
  const bool active = rg * 32 < nq;
  const int kvalid = rg < 2 ? kv_lo : kv_hi;
  float* wsf = (float*)(lds + 131072) + wid * 64; float* li_l = wsf; float* al_l = wsf + 32;
  float m_reg = -1e30f, l_reg = 0; f32x16 o[8];
#pragma unroll
  for (int d = 0; d < 8; ++d) o[d] = f32x16{};
  bf16x8 qr[8];
  { const bf16* Qw = Qb + (long)(rg * 32 + r32) * 2048 + br * 128 + hi * 8;
#pragma unroll
    for (int d0 = 0; d0 < 8; ++d0) qr[d0] = *reinterpret_cast<const bf16x8*>(Qw + d0 * 16); }
#define DMA_TILE(t, buf) do { const char* kt = (const char*)Kh + (size_t)(t) * (64 * 2048 * 2); const char* vt = (const char*)Vh + (size_t)(t) * (64 * 2048 * 2); \
    _Pragma("unroll") for (int i = 0; i < 8; ++i) __builtin_amdgcn_global_load_lds((const unsigned*)((wid < 4 ? kt : vt) + src_off(wid * 8 + i, lane)), (LAS unsigned*)(lds + (buf) * 65536 + (wid * 8 + i) * 1024), 16, 0, 0); } while (0)
  DMA_TILE(0, 0);
  for (int t = 0; t < NT; ++t) {
    asm volatile("s_waitcnt vmcnt(0)" ::: "memory");
    __builtin_amdgcn_s_barrier();
    if (t + 1 < NT) DMA_TILE(t + 1, (t + 1) & 1);
    const int rem = kvalid - 64 * t;
    if (active && rem > 0) {
      const bf16* Ks = (const bf16*)(lds + (t & 1) * 65536 + br * 16384);
      const int vb = (int)(uintptr_t)(lds + (t & 1) * 65536 + 32768) + v_rd_base(lane);
      f32x16 p0, p1; float mn, al; bf16x8 pa0, pa1, pa2, pa3;
      p0 = f32x16{}; p1 = f32x16{};
#pragma unroll
      for (int d0 = 0; d0 < 8; ++d0) { const int cb = (d0 * 16 + hi * 8) * 2;
        const bf16x8 b0 = *reinterpret_cast<const bf16x8*>((const char*)Ks + KSWZ(r32, cb));
        const bf16x8 b1 = *reinterpret_cast<const bf16x8*>((const char*)Ks + KSWZ(32 + r32, cb));
        p0 = __builtin_amdgcn_mfma_f32_32x32x16_bf16(b0, qr[d0], p0, 0, 0, 0);
        p1 = __builtin_amdgcn_mfma_f32_32x32x16_bf16(b1, qr[d0], p1, 0, 0, 0);
        }
      partialSM(p0, p1, m_reg, mn, al, rem, hi);
      if (__any(al < 1.f)) { if (hi == 0) al_l[r32] = al; asm volatile("s_waitcnt lgkmcnt(0)" ::: "memory");
#pragma unroll
        for (int d = 0; d < 8; ++d)
#pragma unroll
          for (int r = 0; r < 16; ++r) o[d][r] *= al_l[crow(r, hi)]; }
      finishSM(p0, p1, al, l_reg, pa0, pa1, pa2, pa3); SBAR();
      pv_one8<0>(o[0], vb, pa0, pa1, pa2, pa3); pv_one8<1>(o[1], vb, pa0, pa1, pa2, pa3); pv_one8<2>(o[2], vb, pa0, pa1, pa2, pa3); pv_one8<3>(o[3], vb, pa0, pa1, pa2, pa3);
      pv_one8<4>(o[4], vb, pa0, pa1, pa2, pa3); pv_one8<5>(o[5], vb, pa0, pa1, pa2, pa3); pv_one8<6>(o[6], vb, pa0, pa1, pa2, pa3); pv_one8<7>(o[7], vb, pa0, pa1, pa2, pa3);
    }
  }
#undef DMA_TILE
  if (hi == 0) li_l[r32] = l_reg; asm volatile("s_waitcnt lgkmcnt(0)" ::: "memory");
  float rli[16];
#pragma unroll
  for (int r = 0; r < 16; ++r) rli[r] = __builtin_amdgcn_rcpf(li_l[crow(r, hi)]);
  __builtin_amdgcn_s_barrier();
  float* ex = (float*)lds + (size_t)rg * 8192;
  if (br == 1) {
#pragma unroll
    for (int d = 0; d < 8; ++d)
#pragma unroll
      for (int r = 0; r < 16; ++r) ex[(d * 16 + r) * 64 + lane] = o[d][r] * rli[r] * lam;
  }
  asm volatile("s_waitcnt lgkmcnt(0)" ::: "memory"); __builtin_amdgcn_s_barrier(); asm volatile("" ::: "memory");
  if (br == 0 && active) {
    float ss[16];
#pragma unroll
    for (int r = 0; r < 16; ++r) ss[r] = 0.f;
#pragma unroll
    for (int d = 0; d < 8; ++d)
#pragma unroll
      for (int r = 0; r < 16; ++r) { const float v = o[d][r] * rli[r] - ex[(d * 16 + r) * 64 + lane]; o[d][r] = v; ss[r] = fmaf(v, v, ss[r]); }
#pragma unroll
    for (int r = 0; r < 16; ++r) { float v = ss[r]; v += xor1(v); v += xor2(v); v += xor4s(v); v += xor8(v); v += xor16(v);
        ss[r] = rsqrtf(v * (1.f / 256.f) + LN_EPS) * (1.f - LAM_INIT); }
#pragma unroll
    for (int d = 0; d < 8; ++d) { const float g = gnorm[32 * d + r32];
#pragma unroll
      for (int r = 0; r < 16; ++r) { const int rk = rg * 32 + (r & 3) + 8 * (r >> 2);
          if (rk + 4 * hi < nq) *(unsigned short*)((unsigned char*)outp + (size_t)rk * 8192 + 64 * d + (unsigned)(hi * (4 * 8192) + r32 * 2)) = (unsigned short)f2bf(o[d][r] * ss[r] * g); } }
  }
  asm volatile("s_waitcnt lgkmcnt(0)" ::: "memory"); __builtin_amdgcn_s_barrier(); asm volatile("" ::: "memory");
}
}
__device__ __forceinline__ unsigned cvt2(float lo, float hi) { const f32x2 v = {lo, hi}; return __builtin_bit_cast(unsigned, __builtin_convertvector(v, bf16x2_t)); }
__device__ __forceinline__ bf16x8 pack_acc(const f32x16& x, int s) {
    v4u p; p.x = cvt2(x[8 * s + 0], x[8 * s + 1]); p.y = cvt2(x[8 * s + 2], x[8 * s + 3]); p.z = cvt2(x[8 * s + 4], x[8 * s + 5]); p.w = cvt2(x[8 * s + 6], x[8 * s + 7]);
    return __builtin_bit_cast(bf16x8, p);
}
__device__ __forceinline__ void gla_scan_unit(Frame& F, int unit) {
    const int half = unit & 1, h = (unit >> 1) & 3, b = unit >> 3;
    int t_ = F.wave * 64 + lane_id_v();
    const int t = t_, lane = t & 63, r32 = t & 31, hi = (t >> 5) & 1; const int wave = F.wave;
    constexpr int STG = 74752;
    const int dvc = 256 * half + 32 * wave + r32;
    bf16* MIXIN = (bf16*)(F.ws + WS_F);
    f32x16 S[8];
#pragma unroll
    for (int i = 0; i < 8; ++i) S[i] = f32x16{};
    const int item0 = (b * 4 + h) * 128;
    const char* QINg = (const char*)(F.ws + WS_QIN) + (size_t)item0 * 32768; const char* KEg = (const char*)(F.ws + WS_KENDT) + (size_t)item0 * 32768;
    const char* AMg = (const char*)(F.ws + WS_AM) + (size_t)item0 * 8192; const char* DECg = (const char*)(F.ws + WS_DEC) + (size_t)item0 * 1024;
    const bf16* VTg = (const bf16*)(F.ws + WS_E) + (size_t)item0 * 512 * 64 + (size_t)dvc * 64 + 8 * hi;
#define SCAN_DMA(c, buf) do { for (int p = wave; p < 73; p += 8) { \
        const char* src = p < 32 ? QINg + (size_t)(c) * 32768 + p * 1024 : p < 64 ? KEg + (size_t)(c) * 32768 + (p - 32) * 1024 : p < 72 ? AMg + (size_t)(c) * 8192 + (p - 64) * 1024 : DECg + (size_t)(c) * 1024; \
        __builtin_amdgcn_global_load_lds((const unsigned*)(src + lane * 16), (LAS unsigned*)(F.lds + (buf) * STG + p * 1024), 16, 0, 0); } } while (0)
    __syncthreads();
    SCAN_DMA(0, 0);
    bf16x8 vt[4];
#pragma unroll
    for (int ks = 0; ks < 4; ++ks) vt[ks] = *(const bf16x8*)(VTg + 16 * ks);
    for (int c = 0; c < 128; ++c) {
        asm volatile("s_waitcnt vmcnt(0)" ::: "memory");
        __builtin_amdgcn_s_barrier(); asm volatile("" ::: "memory");
        bf16x8 vn[4];
#pragma unroll
        for (int ks = 0; ks < 4; ++ks) vn[ks] = vt[ks];
        if (c + 1 < 128) SCAN_DMA(c + 1, (c + 1) & 1);
        const unsigned char* sb = F.lds + (c & 1) * STG;
        const unsigned char* qsm = sb; const unsigned char* ksm = sb + 32768; const unsigned char* asm_ = sb + 65536; const float* dsm = (const float*)(sb + 73728);
        f32x16 o0 = f32x16{}, o1 = f32x16{};
#pragma unroll
        for (int dkt = 0; dkt < 8; ++dkt) {
#pragma unroll
            for (int s = 0; s < 2; ++s) {
                const bf16x8 xs = pack_acc(S[dkt], s);
                const int ch = 2 * (2 * dkt + s) + hi;
                const bf16x8 a0 = *(const bf16x8*)(qsm + r32 * 512 + ((ch ^ r32) << 4)), a1 = *(const bf16x8*)(qsm + (32 + r32) * 512 + ((ch ^ r32) << 4));
                o0 = MFMA32(a0, xs, o0); o1 = MFMA32(a1, xs, o1);
            }
            __builtin_amdgcn_sched_barrier(0);
        }
#pragma unroll
        for (int ks = 0; ks < 4; ++ks) { const int sw = ((2 * ks + hi) ^ ((r32 >> 1) & 7)) << 4;
            const bf16x8 a0 = *(const bf16x8*)(asm_ + r32 * 128 + sw), a1 = *(const bf16x8*)(asm_ + (32 + r32) * 128 + sw);
            o0 = MFMA32(a0, vt[ks], o0); o1 = MFMA32(a1, vt[ks], o1);
        }
        { unsigned char* rowbase = (unsigned char*)MIXIN + (((size_t)b * SEQ + 64 * c) * 4096 + 2048 + h * 512 + 256 * half + 32 * wave) * 2;
          const unsigned lane_off = (unsigned)(hi * (4 * 8192) + r32 * 2);
#pragma unroll
          for (int r = 0; r < 16; ++r) { const int rk = (r & 3) + 8 * (r >> 2);
              *(unsigned short*)(rowbase + (size_t)rk * 8192 + lane_off) = (unsigned short)f2bf(o0[r]); *(unsigned short*)(rowbase + (size_t)(rk + 32) * 8192 + lane_off) = (unsigned short)f2bf(o1[r]); } }
        if (c + 1 < 128) {
#pragma unroll
            for (int ks = 0; ks < 4; ++ks) vn[ks] = *(const bf16x8*)(VTg + (size_t)(c + 1) * 512 * 64 + 16 * ks); }
#pragma unroll
        for (int dkt = 0; dkt < 8; ++dkt) {
#pragma unroll
            for (int g4 = 0; g4 < 4; ++g4) { const f32x4 dv4 = *(const f32x4*)(dsm + 32 * dkt + 8 * g4 + 4 * hi);
#pragma unroll
                for (int e = 0; e < 4; ++e) S[dkt][4 * g4 + e] *= dv4[e]; }
#pragma unroll
            for (int ks = 0; ks < 4; ++ks) { const bf16x8 a = *(const bf16x8*)(ksm + (32 * dkt + r32) * 128 + (((2 * ks + hi) ^ ((r32 >> 1) & 7)) << 4)); S[dkt] = MFMA32(a, vt[ks], S[dkt]); }
            __builtin_amdgcn_sched_barrier(0);
        }
#pragma unroll
        for (int ks = 0; ks < 4; ++ks) vt[ks] = vn[ks];
    }
#undef SCAN_DMA
    float* SO = F.out + O_GP + ((size_t)(b * 4 + h) * 256) * 512 + dvc;
#pragma unroll
    for (int dkt = 0; dkt < 8; ++dkt)
#pragma unroll
        for (int r = 0; r < 16; ++r) SO[(size_t)(32 * dkt + crow(r, hi)) * 512] = S[dkt][r];
    asm volatile("s_waitcnt vmcnt(0) lgkmcnt(0)" ::: "memory"); __syncthreads();
}
__device__ __forceinline__ void cvt_tables_unit(Frame& F, int unit) {
    unsigned char* UQ = F.ws + WS_G; unsigned char* VQ = F.ws + WS_G + 64 * MiB;
    const size_t c0 = (size_t)unit * (32 * DM / 32);
    for (int k = (F.wave * 64 + lane_id_v()); k < 32 * DM / 32; k += 512) { const size_t c = c0 + k;
        f32x4 a[2][8];
#pragma unroll
        for (int tb = 0; tb < 2; ++tb) { const float* src = (tb ? F.peer_v : F.peer_u) + c * 32;
#pragma unroll
            for (int w = 0; w < 8; ++w) a[tb][w] = *(const f32x4*)(src + 4 * w); }
#pragma unroll
        for (int tb = 0; tb < 2; ++tb) { const float sc = tb ? 8.f : 128.f; v4u o;
#pragma unroll
            for (int w = 0; w < 4; ++w) { const f32x4 lo = a[tb][2 * w] * sc, hi = a[tb][2 * w + 1] * sc; unsigned pk = 0u;
                pk = __builtin_amdgcn_cvt_scalef32_pk_fp4_f32(pk, lo[0], lo[1], 1.0f, 0); pk = __builtin_amdgcn_cvt_scalef32_pk_fp4_f32(pk, lo[2], lo[3], 1.0f, 1);
                pk = __builtin_amdgcn_cvt_scalef32_pk_fp4_f32(pk, hi[0], hi[1], 1.0f, 2); pk = __builtin_amdgcn_cvt_scalef32_pk_fp4_f32(pk, hi[2], hi[3], 1.0f, 3); o[w] = pk; }
            *(v4u*)((tb ? VQ : UQ) + c * 16) = o; } }
}
__device__ __forceinline__ void cvt_tables_drain(Frame& F, int max_units) {
    volatile unsigned* slot = (volatile unsigned*)(F.lds + MISC_OFF + 64);
    for (int n = 0; n < max_units; ++n) {
        __syncthreads();
        if ((F.wave * 64 + lane_id_v()) == 0) *slot = __hip_atomic_fetch_add((unsigned*)(F.ctl + CW_QUEUE + 64 * 8), 1u, __ATOMIC_RELAXED, __HIP_MEMORY_SCOPE_AGENT);
        __syncthreads();
        const int u = __builtin_amdgcn_readfirstlane((int)*slot);
        if (u >= 512) break;
        cvt_tables_unit(F, u);
    }
}
__device__ __forceinline__ void p3b_finalize(Frame& F, bool dummy, int gw, int NGW, int MEND) {
    const int lane = lane_id_v();
    bf16* MIXIN = (bf16*)(F.ws + WS_F); const bf16* GR = (const bf16*)(F.ws + WS_D + 2 * SZ_TOK2048);
    const f32x4 g0 = *(const f32x4*)(F.gng + 8 * lane), g1 = *(const f32x4*)(F.gng + 8 * lane + 4);
    v4u rawn[4], grn[4];
#pragma unroll
    for (int h = 0; h < 4; ++h) { rawn[h] = *(const v4u*)(MIXIN + (size_t)gw * 4096 + 2048 + h * 512 + 8 * lane); grn[h] = *(const v4u*)(GR + (size_t)gw * 2048 + h * 512 + 8 * lane); }
    for (int m = gw; m < MEND; m += NGW) {
        v4u raw[4], gr[4];
#pragma unroll
        for (int h = 0; h < 4; ++h) { raw[h] = rawn[h]; gr[h] = grn[h]; }
        if (m + NGW < MEND) {
#pragma unroll
            for (int h = 0; h < 4; ++h) { rawn[h] = *(const v4u*)(MIXIN + (size_t)(m + NGW) * 4096 + 2048 + h * 512 + 8 * lane); grn[h] = *(const v4u*)(GR + (size_t)(m + NGW) * 2048 + h * 512 + 8 * lane); } }
#pragma unroll
        for (int h = 0; h < 4; ++h) {
            const float x[8] = {bflo(raw[h].x), bfhi(raw[h].x), bflo(raw[h].y), bfhi(raw[h].y), bflo(raw[h].z), bfhi(raw[h].z), bflo(raw[h].w), bfhi(raw[h].w)};
            const float gg[8] = {bflo(gr[h].x), bfhi(gr[h].x), bflo(gr[h].y), bfhi(gr[h].y), bflo(gr[h].z), bfhi(gr[h].z), bflo(gr[h].w), bfhi(gr[h].w)};
            float ss = 0.f;
#pragma unroll
            for (int e = 0; e < 8; ++e) ss += x[e] * x[e];
            ss = wave_sum(ss); const float rs = rsqrtf(ss * (1.f / 512.f) + LN_EPS);
            float y[8];
#pragma unroll
            for (int e = 0; e < 8; ++e) { const float gn = e < 4 ? g0[e & 3] : g1[e & 3]; const float sl = gg[e] / (1.f + __expf(-gg[e])); y[e] = x[e] * rs * gn * sl; }
            bf16* p = (dummy ? (bf16*)(F.ws + WS_C) : MIXIN) + (size_t)m * 4096 + 2048 + h * 512 + 8 * lane;
            *(v4u*)p = (v4u){pk2(y[0], y[1]), pk2(y[2], y[3]), pk2(y[4], y[5]), pk2(y[6], y[7])};
        }
    }
}
__device__ __forceinline__ void p3_attn_scan(Frame& F) {
    volatile unsigned* slot = (volatile unsigned*)(F.lds + MISC_OFF + 64);
    const bf16* QB = (const bf16*)(F.ws + WS_C); const bf16* KB = (const bf16*)(F.ws + WS_C + SZ_TOK2048); const bf16* VB = (const bf16*)(F.ws + WS_C + 2 * SZ_TOK2048);
    const bf16* KSB = (const bf16*)(F.ws + WS_H); const bf16* VSB = (const bf16*)(F.ws + WS_H + 72 * MiB);
    bf16* MIXIN = (bf16*)(F.ws + WS_F);
    float lam;
    { const int lane = lane_id_v(); const float s1 = wave_sum(F.lq1[lane] * F.lk1[lane] + F.lq1[lane + 64] * F.lk1[lane + 64]);
      const float s2 = wave_sum(F.lq2[lane] * F.lk2[lane] + F.lq2[lane + 64] * F.lk2[lane + 64]);
      lam = expf(s1) - expf(s2) + LAM_INIT; }
    constexpr int QN = 2 + 8 + 128 + 16;
    bool fin_done = false;
    const int q0 = (int)(xb_xcc_id() & 7u);
    for (int dq = 0; dq < 8; ++dq) {
      const int q = (q0 + dq) & 7;
      for (;;) {
        __syncthreads();
        if ((F.wave * 64 + lane_id_v()) == 0) *slot = __hip_atomic_fetch_add((unsigned*)(F.ctl + CW_QUEUE + 64 * q), 1u, __ATOMIC_RELAXED, __HIP_MEMORY_SCOPE_AGENT);
        __syncthreads();
        const int u = __builtin_amdgcn_readfirstlane((int)*slot);
        if (u >= QN) break;
#ifndef NREP_S
#define NREP_S 1
#endif
        if (u < 10) {
            if (u < 2) { for (int rr = 0; rr < NREP_S; ++rr) gla_scan_unit(F, 2 * q + u); } else gla_sample_item(F, 8 * q + (u - 2));
            asm volatile("s_waitcnt vmcnt(0)" ::: "memory"); __syncthreads();
            if ((F.wave * 64 + lane_id_v()) == 0) { __builtin_amdgcn_fence(__ATOMIC_RELEASE, "agent"); asm volatile("s_waitcnt vmcnt(0)" ::: "memory");
                (void)__hip_atomic_fetch_add((unsigned*)(F.ctl + CW_QUEUE + 64 * 10), 1u, __ATOMIC_RELAXED, __HIP_MEMORY_SCOPE_AGENT); }
            continue; }
        int v = u - 10;
        const bf16 *Qp, *Kp, *Vp; bf16* Op; int nq, kv_lo, kv_hi, NT;
        if (v < 128) {
            const int a = v, jb = 63 - (a >> 1), pr = 2 * q + (a & 1), h = pr & 7, b = pr >> 3;
            const size_t row0 = (size_t)b * SEQ;
            Kp = KB + row0 * 2048 + h * 256; Vp = VB + row0 * 2048 + h * 256; Qp = QB + (row0 + 128 * jb) * 2048 + h * 256;
            Op = MIXIN + (row0 + 128 * jb) * 4096 + h * 256; nq = 128; kv_lo = 64 * (2 * jb + 1); kv_hi = 64 * (2 * jb + 2); NT = 2 * jb + 2;
        } else {
            v -= 128; const int h = v & 7, sb = 2 * q + (v >> 3);
            const size_t rowq = (size_t)TP + sb * 16;
            Kp = KSB + (size_t)sb * 1152 * 2048 + h * 256; Vp = VSB + (size_t)sb * 1152 * 2048 + h * 256; Qp = QB + rowq * 2048 + h * 256;
            Op = MIXIN + rowq * 4096 + h * 256; nq = 16; kv_lo = 1040; kv_hi = 1040; NT = 17;
        }
#ifndef NREP_A
#define NREP_A 1
#endif
        for (int rr = 0; rr < NREP_A; ++rr) dat::dattn_unit(Qp, Kp, Vp, nq, kv_lo, kv_hi, NT, Op, F.dng, lam, F.lds, F.wave * 64 + lane_id_v());
        if (!fin_done) {
            __syncthreads();
            if ((F.wave * 64 + lane_id_v()) == 0) { unsigned r = 0xffffffffu;
                if (__hip_atomic_load((unsigned*)(F.ctl + CW_QUEUE + 64 * 10), __ATOMIC_RELAXED, __HIP_MEMORY_SCOPE_AGENT) >= 80u) r = __hip_atomic_fetch_add((unsigned*)(F.ctl + CW_QUEUE + 64 * 11), 1u, __ATOMIC_RELAXED, __HIP_MEMORY_SCOPE_AGENT);
                *slot = r; }
            __syncthreads();
            const unsigned fu = (unsigned)__builtin_amdgcn_readfirstlane((int)*slot);
            if (fu != 0xffffffffu) {
                if (fu >= (unsigned)(MTOK / 64)) fin_done = true;
                else { __builtin_amdgcn_fence(__ATOMIC_ACQUIRE, "agent"); asm volatile("s_waitcnt vmcnt(0)" ::: "memory"); p3b_finalize(F, false, 64 * (int)fu + F.wave, 8, 64 * (int)fu + 64); }
            }
        }
      }
    }
    if ((F.wave * 64 + lane_id_v()) == 0) { unsigned sp = 0; while (__hip_atomic_load((unsigned*)(F.ctl + CW_QUEUE + 64 * 10), __ATOMIC_RELAXED, __HIP_MEMORY_SCOPE_AGENT) < 80u && ++sp < (1u << 22)) __builtin_amdgcn_s_sleep(8); }
    __syncthreads(); __builtin_amdgcn_fence(__ATOMIC_ACQUIRE, "agent"); asm volatile("s_waitcnt vmcnt(0)" ::: "memory");
    for (;;) {
        __syncthreads();
        if ((F.wave * 64 + lane_id_v()) == 0) *slot = __hip_atomic_fetch_add((unsigned*)(F.ctl + CW_QUEUE + 64 * 11), 1u, __ATOMIC_RELAXED, __HIP_MEMORY_SCOPE_AGENT);
        __syncthreads();
        const int u2 = __builtin_amdgcn_readfirstlane((int)*slot);
        if (u2 >= MTOK / 64) break;
        p3b_finalize(F, false, 64 * u2 + F.wave, 8, 64 * u2 + 64);
    }
}
__device__ __forceinline__ void p5_ln1(Frame& F, bool dummy) {
    const int gw = F.bid * NWAVES + F.wave, NGW = F.G * NWAVES, lane = lane_id_v();
    bf16* X1B = (bf16*)(F.ws + WS_A);
    v4u wn[8];
#pragma unroll
    for (int k = 0; k < 8; ++k) wn[k] = *(const v4u*)(X1B + (size_t)gw * DM + 8 * (lane + 64 * k));
    for (int m = gw; m < MTOK; m += NGW) {
        bf16* xr = X1B + (size_t)m * DM; float v[8][8]; float s = 0.f;
#pragma unroll
        for (int k = 0; k < 8; ++k) { const unsigned ww[4] = {wn[k].x, wn[k].y, wn[k].z, wn[k].w};
#pragma unroll
            for (int e = 0; e < 4; ++e) { v[k][2 * e] = __uint_as_float(ww[e] << 16); v[k][2 * e + 1] = __uint_as_float(ww[e] & 0xffff0000u); s += v[k][2 * e] + v[k][2 * e + 1]; } }
        if (m + NGW < MTOK) {
#pragma unroll
            for (int k = 0; k < 8; ++k) wn[k] = *(const v4u*)(xr + (size_t)NGW * DM + 8 * (lane + 64 * k)); }
        const float mean = wave_sum(s) * (1.f / DM); float s2 = 0.f;
#pragma unroll
        for (int k = 0; k < 8; ++k)
#pragma unroll
            for (int e = 0; e < 8; ++e) { v[k][e] -= mean; s2 += v[k][e] * v[k][e]; }
        const float rstd = rsqrtf(wave_sum(s2) * (1.f / DM) + LN_EPS);
#pragma unroll
        for (int k = 0; k < 8; ++k) { const int c = 8 * (lane + 64 * k);
            const f32x4 g0 = *(const f32x4*)(F.ln1g + c), g1 = *(const f32x4*)(F.ln1g + c + 4), b0 = *(const f32x4*)(F.ln1b + c), b1 = *(const f32x4*)(F.ln1b + c + 4);
            v4u w; w.x = pk2(v[k][0] * rstd * g0[0] + b0[0], v[k][1] * rstd * g0[1] + b0[1]); w.y = pk2(v[k][2] * rstd * g0[2] + b0[2], v[k][3] * rstd * g0[3] + b0[3]);
            w.z = pk2(v[k][4] * rstd * g1[0] + b1[0], v[k][5] * rstd * g1[1] + b1[1]); w.w = pk2(v[k][6] * rstd * g1[2] + b1[2], v[k][7] * rstd * g1[3] + b1[3]);
            *(v4u*)((dummy ? (bf16*)(F.ws + WS_E) + (size_t)(m & 4095) * DM : xr) + c) = w; }
    }
}
__device__ __forceinline__ int mono(float f) { return __builtin_bit_cast(int, f); }
__device__ __forceinline__ float unmono(int s) { return __builtin_bit_cast(float, s); }
__device__ __forceinline__ int kmax(int a, int b) { int r; asm("v_max_f32 %0, %1, %2" : "=v"(r) : "v"(a), "v"(b)); return r; }
__device__ __forceinline__ int kmin(int a, int b) { int r; asm("v_min_f32 %0, %1, %2" : "=v"(r) : "v"(a), "v"(b)); return r; }
#define CE_DESC(A, i_, j_) do { const int a_ = A[i_], b_ = A[j_]; A[i_] = kmax(a_, b_); A[j_] = kmin(a_, b_); } while (0)
__device__ __forceinline__ void sort16_desc(int (&A)[16]) {
    CE_DESC(A, 0, 13); CE_DESC(A, 1, 12); CE_DESC(A, 2, 15); CE_DESC(A, 3, 14); CE_DESC(A, 4, 8); CE_DESC(A, 5, 6); CE_DESC(A, 7, 11); CE_DESC(A, 9, 10);
    CE_DESC(A, 0, 5); CE_DESC(A, 1, 7); CE_DESC(A, 2, 9); CE_DESC(A, 3, 4); CE_DESC(A, 6, 13); CE_DESC(A, 8, 14); CE_DESC(A, 10, 15); CE_DESC(A, 11, 12);
    CE_DESC(A, 0, 1); CE_DESC(A, 2, 3); CE_DESC(A, 4, 5); CE_DESC(A, 6, 8); CE_DESC(A, 7, 9); CE_DESC(A, 10, 11); CE_DESC(A, 12, 13); CE_DESC(A, 14, 15);
    CE_DESC(A, 0, 2); CE_DESC(A, 1, 3); CE_DESC(A, 4, 10); CE_DESC(A, 5, 11); CE_DESC(A, 6, 7); CE_DESC(A, 8, 9); CE_DESC(A, 12, 14); CE_DESC(A, 13, 15);
    CE_DESC(A, 1, 2); CE_DESC(A, 3, 12); CE_DESC(A, 4, 6); CE_DESC(A, 5, 7); CE_DESC(A, 8, 10); CE_DESC(A, 9, 11); CE_DESC(A, 13, 14);
    CE_DESC(A, 1, 4); CE_DESC(A, 2, 6); CE_DESC(A, 5, 8); CE_DESC(A, 7, 10); CE_DESC(A, 9, 13); CE_DESC(A, 11, 14);
    CE_DESC(A, 2, 4); CE_DESC(A, 3, 6); CE_DESC(A, 9, 12); CE_DESC(A, 11, 13);
    CE_DESC(A, 3, 5); CE_DESC(A, 6, 8); CE_DESC(A, 7, 9); CE_DESC(A, 10, 12);
    CE_DESC(A, 3, 4); CE_DESC(A, 5, 6); CE_DESC(A, 7, 8); CE_DESC(A, 9, 10); CE_DESC(A, 11, 12);
    CE_DESC(A, 6, 7); CE_DESC(A, 8, 9);
}
__device__ __forceinline__ void merge16_desc(int (&A)[16], const int (&B)[16]) {
#pragma unroll
    for (int q = 0; q < 16; ++q) A[q] = kmax(A[q], B[15 - q]);
#pragma unroll
    for (int dd = 8; dd >= 1; dd >>= 1)
#pragma unroll
        for (int q = 0; q < 16; ++q) if ((q & dd) == 0) CE_DESC(A, q, q + dd);
}
__device__ __forceinline__ void top16_of_128(const f32x16 (&sc)[4], int hi, int (&L)[16]) {
    int G[16];
#pragma unroll
    for (int kt = 0; kt < 4; ++kt) {
#pragma unroll
        for (int r = 0; r < 16; ++r) { const int key = 32 * kt + (r & 3) + 8 * (r >> 2) + 4 * hi; G[r] = (mono(sc[kt][r]) & ~127) | key; }
        sort16_desc(G);
        if (kt == 0) {
#pragma unroll
            for (int q = 0; q < 16; ++q) L[q] = G[q];
        } else merge16_desc(L, G);
        __builtin_amdgcn_sched_barrier(0);
    }
#pragma unroll
    for (int q = 0; q < 16; ++q) { const auto rr = __builtin_amdgcn_permlane32_swap((unsigned)L[q], (unsigned)L[q], false, false); G[q] = (int)(hi ? rr[0] : rr[1]); }
    merge16_desc(L, G);
}
__device__ __forceinline__ void p7_peer_select(Frame& F) {
    int t_ = F.wave * 64 + lane_id_v();
    const int tid = t_, lane = t_ & 63, r32 = lane & 31, hi = lane >> 5, wave = F.wave;
    const bf16* QP = (const bf16*)(F.ws + WS_B); const bf16* KEYB = (const bf16*)(F.ws + WS_KEYB);
    int* IDX = (int*)(F.ws + WS_IDX); float* GATE = (float*)(F.ws + WS_GATE);
    const int h = F.bid & 7, g = F.bid >> 3;
    unsigned char* ks = F.lds;
    __syncthreads();
    { v4u kv[8];
#pragma unroll
      for (int i = 0; i < 8; ++i) { const int k = tid + 512 * i; const int half = k >> 11, key = (k >> 4) & 127, pc = k & 15; kv[i] = *(const v4u*)(KEYB + ((size_t)(half * 8 + h) * 128 + key) * 128 + 8 * pc); }
#pragma unroll
      for (int i = 0; i < 8; ++i) { const int k = tid + 512 * i; const int half = k >> 11, key = (k >> 4) & 127, pc = k & 15; *(v4u*)(ks + (half * 128 + key) * 272 + 16 * pc) = kv[i]; } }
    __syncthreads();
    for (int kk = wave; g + 32 * kk < MTOK / 32; kk += 8) {
        const int tt = g + 32 * kk; const int tok = 32 * tt + r32;
        int T1[16], T2[16];
#pragma unroll
        for (int half = 0; half < 2; ++half) {
            f32x16 sc[4];
#pragma unroll
            for (int kt = 0; kt < 4; ++kt) sc[kt] = f32x16{};
            const char* qb = (const char*)(QP + (size_t)(32 * tt) * 2048 + h * 256 + half * 128);
            unsigned qoff = (unsigned)(r32 * 4096 + hi * 16); asm volatile("" : "+v"(qoff));
            bf16x8 bq[8];
#pragma unroll
            for (int s = 0; s < 8; ++s) bq[s] = *(const bf16x8*)(qb + 32 * s + qoff);
            const unsigned char* kb = ks + half * (128 * 272) + r32 * 272 + hi * 16;
#pragma unroll
            for (int s = 0; s < 8; ++s) {
#pragma unroll
                for (int kt = 0; kt < 4; ++kt) { const bf16x8 a = *(const bf16x8*)(kb + kt * (32 * 272) + 32 * s); sc[kt] = MFMA32(a, bq[s], sc[kt]); }
                if (s & 1) __builtin_amdgcn_sched_barrier(0); }
            if (half == 0) top16_of_128(sc, hi, T1); else top16_of_128(sc, hi, T2);
            __builtin_amdgcn_sched_barrier(0);
        }
        int C[16], Gc[16];
#pragma unroll
        for (int grp = 0; grp < 4; ++grp) {
#pragma unroll
            for (int q = 0; q < 16; ++q) Gc[q] = (int)0xff800000;
            { int n = 0, slot = 0;
#pragma unroll
              for (int a = 0; a < 16; ++a)
#pragma unroll
                  for (int bq = 0; bq < 16; ++bq) if ((a + 1) * (bq + 1) <= 16) { if (n / 16 == grp) { Gc[slot] = (mono(unmono(T1[a] & ~127) + unmono(T2[bq] & ~127)) & ~255) | (a * 16 + bq); ++slot; } ++n; } }
            if (grp == 3) CE_DESC(Gc, 0, 1); else sort16_desc(Gc);
            if (grp == 0) {
#pragma unroll
                for (int q = 0; q < 16; ++q) C[q] = Gc[q];
            } else merge16_desc(C, Gc);
            __builtin_amdgcn_sched_barrier(0);
        }
        float best[8]; int eidx[8]; float den = 0.f;
#pragma unroll
        for (int i = 0; i < 8; ++i) {
            const int cq = C[i] ^ ((C[i] ^ C[8 + i]) & -hi);
            const int code = cq & 255, ca = code >> 4, cb = code & 15; int i1 = 0, i2 = 0;
#pragma unroll
            for (int a = 0; a < 16; ++a) { i1 = (ca == a) ? (T1[a] & 127) : i1; i2 = (cb == a) ? (T2[a] & 127) : i2; }
            eidx[i] = i1 * 128 + i2;
            best[i] = __expf(unmono(cq & ~255) - unmono(C[0] & ~255)); den += best[i];
        }
        { const auto rr = __builtin_amdgcn_permlane32_swap(__float_as_uint(den), __float_as_uint(den), false, false); den = __uint_as_float(rr[0]) + __uint_as_float(rr[1]); }
        const float rden = 1.f / den;
        { int* ip = IDX + (size_t)tok * 128 + h * 16 + 8 * hi; float* gp = GATE + (size_t)tok * 128 + h * 16 + 8 * hi;
#pragma unroll
          for (int q = 0; q < 8; q += 4) { *(int4*)(ip + q) = make_int4(eidx[q], eidx[q + 1], eidx[q + 2], eidx[q + 3]); *(f32x4*)(gp + q) = (f32x4){best[q] * rden, best[q + 1] * rden, best[q + 2] * rden, best[q + 3] * rden}; } }
    }
}
__device__ __forceinline__ float dot2bf(unsigned w, unsigned x, float acc) { return __builtin_amdgcn_fdot2_f32_bf16(__builtin_bit_cast(bf16x2_t, w), __builtin_bit_cast(bf16x2_t, x), acc, false); }
__device__ __forceinline__ float gelu_erf(float x) { return 0.5f * x * (1.f + erff(x * 0.70710678118654752f)); }
typedef _Float16 h16x2 __attribute__((ext_vector_type(2)));
__device__ __forceinline__ float cf_pack(float c) { const _Float16 h = (_Float16)c; return __builtin_bit_cast(float, (h16x2){h, h}); }
__device__ __forceinline__ void p8_peer_gather(Frame& F) {
    int t_ = F.wave * 64 + lane_id_v();
    const int tid = t_, lane = tid & 63, wave = F.wave, sub = lane & 7, pg = lane >> 3;
    unsigned* idx_s = (unsigned*)F.lds;
    float* cf_s = (float*)(F.lds + 33280);
    float* part_s = (float*)(F.lds + 2 * 33280);
    unsigned char* xs_base = F.lds + 2 * 33280 + 4096 + wave * 10240;
    const bf16* X1B = (const bf16*)(F.ws + WS_A); const char* UQ = (const char*)(F.ws + WS_G); const char* VQ = (const char*)(F.ws + WS_G + 64 * MiB);
    const int* IDX = (const int*)(F.ws + WS_IDX); const float* GATE = (const float*)(F.ws + WS_GATE);
    float* Y = F.out + O_Y;
    __syncthreads();
    { int iv[17]; float gv[17];
#pragma unroll
      for (int i = 0; i < 17; ++i) { const int k = tid + 512 * i; if (k < 65 * 128) { const size_t m = (size_t)F.bid + 256 * (k >> 7); iv[i] = IDX[m * 128 + (k & 127)]; gv[i] = GATE[m * 128 + (k & 127)]; } }
#pragma unroll
      for (int i = 0; i < 17; ++i) { const int k = tid + 512 * i; if (k < 65 * 128) { const int j = k >> 7, p = k & 127; const int pos = j * 128 + (p & 7) * 16 + (p >> 3);
          idx_s[pos] = (unsigned)iv[i] * 2048u; cf_s[pos] = gv[i]; } } }
    __syncthreads();
    float acc[9][16];
#pragma unroll
    for (int q = 0; q < 9; ++q)
#pragma unroll
        for (int i = 0; i < 16; ++i) acc[q][i] = 0.f;
#ifndef NREP_U
#define NREP_U 1
#endif
#ifndef NREP_V
#define NREP_V 1
#endif
    { const int tsl = lane >> 5, pc = lane & 31;
#pragma unroll
      for (int r = 0; r < 5; ++r) { const int q = 2 * r + tsl; const int j = q < 8 ? wave + 8 * q : 64;
          __builtin_amdgcn_global_load_lds((const unsigned*)(X1B + ((size_t)F.bid + 256 * j) * DM + 8 * pc), (LAS unsigned*)(xs_base + 1024 * r), 16, 0, 0); } }
    v4u d[16];
    { const unsigned uo0 = sub * 16;
#pragma unroll
      for (int g = 0; g < 4; ++g) { const v4u iv = *(const v4u*)(idx_s + wave * 128 + pg * 16 + 4 * g);
          d[4 * g] = *(const v4u*)(UQ + (size_t)(iv.x + uo0)); d[4 * g + 1] = *(const v4u*)(UQ + (size_t)(iv.y + uo0)); d[4 * g + 2] = *(const v4u*)(UQ + (size_t)(iv.z + uo0)); d[4 * g + 3] = *(const v4u*)(UQ + (size_t)(iv.w + uo0)); } }
    for (int s_ = 0; s_ < 16 * NREP_U; ++s_) { const int s = s_ & 15;
        if (NREP_U > 1 && s_ == 16) {
#pragma unroll
            for (int q = 0; q < 9; ++q)
#pragma unroll
                for (int i = 0; i < 16; ++i) acc[q][i] = 0.f;
        }
        if (s_ == 0) asm volatile("s_waitcnt vmcnt(0) lgkmcnt(0)" ::: "memory"); else asm volatile("s_waitcnt vmcnt(16) lgkmcnt(0)" ::: "memory");
        if (s_ + 1 < 16 * NREP_U) { const int tsl = lane >> 5, pc = lane & 31;
#pragma unroll
          for (int r = 0; r < 5; ++r) { const int q = 2 * r + tsl; const int j = q < 8 ? wave + 8 * q : 64;
              __builtin_amdgcn_global_load_lds((const unsigned*)(X1B + ((size_t)F.bid + 256 * j) * DM + 256 * ((s + 1) & 15) + 8 * pc), (LAS unsigned*)(xs_base + ((s_ + 1) & 1) * 5120 + 1024 * r), 16, 0, 0); } }
        const unsigned char* xs_w = xs_base + (s_ & 1) * 5120;
        const unsigned uoff = s * 128 + sub * 16;
#pragma unroll
        for (int q = 0; q < 9; ++q) { const int j = q < 8 ? wave + 8 * q : 64;
            if (q < 8 ? (wave + 8 * q < 65) : ((s & 7) == wave)) {
                const bool v8 = (s & 7) == wave, nsame = (q < 7) || (q == 7 && v8), nlast = !nsame && !(s_ + 1 < 16 * NREP_U);
                const int nj = nsame ? (q + 1 < 8 ? wave + 8 * (q + 1) : 64) : (nlast ? j : wave);
                const unsigned noff = (nsame || nlast) ? uoff : ((s + 1) & 15) * 128 + sub * 16;
#pragma unroll
                for (int ch = 0; ch < 2; ++ch) {
                    const v4u xr0 = *(const v4u*)(xs_w + q * 512 + 64 * sub + 32 * ch), xr1 = *(const v4u*)(xs_w + q * 512 + 64 * sub + 32 * ch + 16);
                    const unsigned xw[8] = {xr0.x, xr0.y, xr0.z, xr0.w, xr1.x, xr1.y, xr1.z, xr1.w};
#pragma unroll
                    for (int i = 0; i < 16; ++i) { float a = acc[q][i];
#pragma unroll
                        for (int w = 0; w < 2; ++w) { const unsigned dw = d[i][2 * ch + w];
                            a = __builtin_amdgcn_fdot2_f32_bf16(__builtin_amdgcn_cvt_scalef32_pk_bf16_fp4(dw, 1.0f, 0), __builtin_bit_cast(bf16x2_t, xw[4 * w]), a, false);
                            a = __builtin_amdgcn_fdot2_f32_bf16(__builtin_amdgcn_cvt_scalef32_pk_bf16_fp4(dw, 1.0f, 1), __builtin_bit_cast(bf16x2_t, xw[4 * w + 1]), a, false);
                            a = __builtin_amdgcn_fdot2_f32_bf16(__builtin_amdgcn_cvt_scalef32_pk_bf16_fp4(dw, 1.0f, 2), __builtin_bit_cast(bf16x2_t, xw[4 * w + 2]), a, false);
                            a = __builtin_amdgcn_fdot2_f32_bf16(__builtin_amdgcn_cvt_scalef32_pk_bf16_fp4(dw, 1.0f, 3), __builtin_bit_cast(bf16x2_t, xw[4 * w + 3]), a, false); }
                        acc[q][i] = a;
                        if (ch == 1) {
                            d[i] = *(const v4u*)(UQ + (size_t)(idx_s[nj * 128 + pg * 16 + i] + noff)); } }
                }
            }
        }
    }
#pragma unroll
    for (int q = 0; q < 9; ++q) { const int j = q < 8 ? wave + 8 * q : 64;
#pragma unroll
        for (int i = 0; i < 16; ++i) { float v = acc[q][i]; v += xor1(v); v += xor2(v); v += xor4s(v);
            if (sub == 0) { if (q < 8) { const int pos = j * 128 + pg * 16 + i; cf_s[pos] = cf_pack(cf_s[pos] * gelu_erf(v * 0.0078125f) * 0.125f); } else part_s[wave * 128 + pg * 16 + i] = v; } } }
    __syncthreads();
    if (tid < 128) { float v = 0.f;
#pragma unroll
        for (int w = 0; w < 8; ++w) v += part_s[w * 128 + tid];
        cf_s[64 * 128 + tid] = cf_pack(cf_s[64 * 128 + tid] * gelu_erf(v * 0.0078125f) * 0.125f); }
    __syncthreads();
    { const unsigned vo0 = sub * 16;
#pragma unroll
      for (int g = 0; g < 4; ++g) { const v4u iv = *(const v4u*)(idx_s + wave * 128 + pg * 16 + 4 * g);
          d[4 * g] = *(const v4u*)(VQ + (size_t)(iv.x + vo0)); d[4 * g + 1] = *(const v4u*)(VQ + (size_t)(iv.y + vo0)); d[4 * g + 2] = *(const v4u*)(VQ + (size_t)(iv.z + vo0)); d[4 * g + 3] = *(const v4u*)(VQ + (size_t)(iv.w + vo0)); } }
    for (int s_ = 0; s_ < 16 * NREP_V; ++s_) { const int s = s_ & 15;
        const unsigned voff = s * 128 + sub * 16;
        const int jend = (s & 7) == wave ? 72 : 64;
#pragma unroll 1
        for (int jj = wave; jj < jend; jj += 8) { const int j = jj < 64 ? jj : 64;
            const bool nsame = jj + 8 < jend, nlast = !nsame && !(s_ + 1 < 16 * NREP_V);
            const int nj = nsame ? (jj + 8 < 64 ? jj + 8 : 64) : (nlast ? j : wave);
            const unsigned noff = (nsame || nlast) ? voff : ((s + 1) & 15) * 128 + sub * 16;
            bf16* yp = (bf16*)X1B + ((size_t)F.bid + 256 * j) * DM + 256 * s + 32 * sub + 16 * (pg >> 2) + 4 * (pg & 3);
            const bool wr = s_ >= 16 * (NREP_V - 1);
            v2u xw4 = {0u, 0u};
            if (wr) xw4 = *(const v2u*)yp;
            const f32x4 c0 = *(const f32x4*)(cf_s + j * 128 + pg * 16), c1 = *(const f32x4*)(cf_s + j * 128 + pg * 16 + 4), c2 = *(const f32x4*)(cf_s + j * 128 + pg * 16 + 8), c3 = *(const f32x4*)(cf_s + j * 128 + pg * 16 + 12);
            const float cc[16] = {c0[0], c0[1], c0[2], c0[3], c1[0], c1[1], c1[2], c1[3], c2[0], c2[1], c2[2], c2[3], c3[0], c3[1], c3[2], c3[3]};
            h16x2 ya[16];
#pragma unroll
            for (int e = 0; e < 16; ++e) ya[e] = (h16x2){(_Float16)0.f, (_Float16)0.f};
#pragma unroll
            for (int i = 0; i < 16; ++i) { const h16x2 cf2 = __builtin_bit_cast(h16x2, cc[i]);
#pragma unroll
                for (int w = 0; w < 4; ++w) { ya[4 * w] += cf2 * __builtin_amdgcn_cvt_scalef32_pk_f16_fp4(d[i][w], 1.0f, 0); ya[4 * w + 1] += cf2 * __builtin_amdgcn_cvt_scalef32_pk_f16_fp4(d[i][w], 1.0f, 1);
                    ya[4 * w + 2] += cf2 * __builtin_amdgcn_cvt_scalef32_pk_f16_fp4(d[i][w], 1.0f, 2); ya[4 * w + 3] += cf2 * __builtin_amdgcn_cvt_scalef32_pk_f16_fp4(d[i][w], 1.0f, 3); }
                d[i] = *(const v4u*)(VQ + (size_t)(idx_s[nj * 128 + pg * 16 + i] + noff)); }
            h16x2 tt[8];
#pragma unroll
            for (int e = 0; e < 8; ++e) {
                const auto rr = __builtin_amdgcn_permlane32_swap(__builtin_bit_cast(unsigned, ya[e]), __builtin_bit_cast(unsigned, ya[e + 8]), false, false);
                h16x2 t = __builtin_bit_cast(h16x2, (unsigned)rr[0]) + __builtin_bit_cast(h16x2, (unsigned)rr[1]);
                t += __builtin_bit_cast(h16x2, xor16(__builtin_bit_cast(float, t)));
                t += __builtin_bit_cast(h16x2, xor8(__builtin_bit_cast(float, t)));
                tt[e] = t; }
            const int kq = pg & 3;
            const h16x2 ta = kq == 0 ? tt[0] : kq == 1 ? tt[2] : kq == 2 ? tt[4] : tt[6], tb = kq == 0 ? tt[1] : kq == 1 ? tt[3] : kq == 2 ? tt[5] : tt[7];
            if (wr) { v2u o2;
                o2.x = pk2(fmaf(ALPHA_RES, __uint_as_float(xw4.x << 16), (float)ta.x), fmaf(ALPHA_RES, __uint_as_float(xw4.x & 0xffff0000u), (float)ta.y));
                o2.y = pk2(fmaf(ALPHA_RES, __uint_as_float(xw4.y << 16), (float)tb.x), fmaf(ALPHA_RES, __uint_as_float(xw4.y & 0xffff0000u), (float)tb.y));
                *(v2u*)yp = o2; }
        }
    }
    VM_WAIT(); __syncthreads(); __builtin_amdgcn_fence(__ATOMIC_ACQUIRE, "agent"); VM_WAIT();
    v4u wn[8];
#pragma unroll
    for (int k = 0; k < 8; ++k) wn[k] = *(const v4u*)(X1B + ((size_t)F.bid + 256 * wave) * DM + 8 * (lane + 64 * k));
    for (int q = 0; q < 9; ++q) { const int j = wave + 8 * q; if (j >= 65) break;
        const size_t m = (size_t)F.bid + 256 * j; float* yr = Y + m * DM; float v[8][8]; float s = 0.f;
#pragma unroll
        for (int k = 0; k < 8; ++k) { const unsigned ww[4] = {wn[k].x, wn[k].y, wn[k].z, wn[k].w};
#pragma unroll
            for (int e = 0; e < 4; ++e) { v[k][2 * e] = __uint_as_float(ww[e] << 16); v[k][2 * e + 1] = __uint_as_float(ww[e] & 0xffff0000u); s += v[k][2 * e] + v[k][2 * e + 1]; } }
        if (j + 8 < 65) {
#pragma unroll
            for (int k = 0; k < 8; ++k) wn[k] = *(const v4u*)(X1B + (m + 2048) * DM + 8 * (lane + 64 * k)); }
        const float mean = wave_sum(s) * (1.f / DM); float s2 = 0.f;
#pragma unroll
        for (int k = 0; k < 8; ++k)
#pragma unroll
            for (int e = 0; e < 8; ++e) { v[k][e] -= mean; s2 += v[k][e] * v[k][e]; }
        const float rstd = rsqrtf(wave_sum(s2) * (1.f / DM) + LN_EPS);
#pragma unroll
        for (int k = 0; k < 8; ++k) { const int c = 8 * (lane + 64 * k);
            const f32x4 g0 = *(const f32x4*)(F.ln2g + c), g1 = *(const f32x4*)(F.ln2g + c + 4), b0 = *(const f32x4*)(F.ln2b + c), b1 = *(const f32x4*)(F.ln2b + c + 4);
            *(f32x4*)(yr + c) = (f32x4){v[k][0] * rstd * g0[0] + b0[0], v[k][1] * rstd * g0[1] + b0[1], v[k][2] * rstd * g0[2] + b0[2], v[k][3] * rstd * g0[3] + b0[3]};
            *(f32x4*)(yr + c + 4) = (f32x4){v[k][4] * rstd * g1[0] + b1[0], v[k][5] * rstd * g1[1] + b1[1], v[k][6] * rstd * g1[2] + b1[2], v[k][7] * rstd * g1[3] + b1[3]}; }
    }
}
#ifndef MK_N_LAUNCHES
#define MK_N_LAUNCHES 1
#endif
constexpr int NPH = 10;
struct Args { const float* in[24]; float* out; unsigned char* ws; int ph_lo, ph_hi; };
__global__ void __launch_bounds__(NWAVES * 64, 2) fwd_kernel(Args args) {
    extern __shared__ __attribute__((aligned(16))) unsigned char lds[];
    Frame F;
    F.lds = lds; F.wave = __builtin_amdgcn_readfirstlane((int)threadIdx.x >> 6); F.G = gridDim.x; F.bid = blockIdx.x;
    F.ws = args.ws; F.out = args.out; F.ctl = (gu32*)(args.ws + WS_CTL);
    F.x_p = args.in[0]; F.x_s = args.in[1]; F.cache_k = args.in[2]; F.cache_v = args.in[3]; F.state = args.in[4]; F.w_in = args.in[5]; F.w_gate2 = args.in[6]; F.b_gate = args.in[7];
    F.lq1 = args.in[8]; F.lk1 = args.in[9]; F.lq2 = args.in[10]; F.lk2 = args.in[11]; F.dng = args.in[12]; F.gng = args.in[13]; F.w_out = args.in[14];
    F.ln1g = args.in[15]; F.ln1b = args.in[16]; F.ln2g = args.in[17]; F.ln2b = args.in[18]; F.peer_wq = args.in[19]; F.keys1 = args.in[20]; F.keys2 = args.in[21]; F.peer_u = args.in[22]; F.peer_v = args.in[23];
    for (int u = ((int)threadIdx.x); u < (LDS_BYTES - MISC_OFF) / 4; u += NWAVES * 64) ((unsigned*)(lds + MISC_OFF))[u] = 0u;
    __syncthreads();
    const int lo = args.ph_lo, hi = args.ph_hi;
    XcdBarrier bar; bar.bar = (unsigned*)(F.ctl + CW_BAR); bar.x = 0; bar.st = nullptr;
    if (hi - lo > 1) bar = xcd_barrier_post((unsigned*)(F.ctl + CW_BAR), (volatile LAS unsigned*)(lds + MISC_OFF));
#ifndef PH_MASK
#define PH_MASK 0x3ff
#endif
#define IN(k) (((PH_MASK >> (k)) & 1) && lo <= (k) && (k) < hi)
#define SEAM(k) do { if (IN(k) && IN((k) + 1)) xcd_barrier(bar); } while (0)
    PG8_LAS unsigned char* glds = (PG8_LAS unsigned char*)lds;
#ifndef REPMASK
#define REPMASK 0
#endif
#define REP(k) ((REPMASK >> (k)) & 1)
    if (IN(0)) { p0_prologue(F); if (REP(0)) p0_prologue(F); SEAM(0); }
    if (IN(1)) {
        pg8::Gemm g{(const pg8::bf16_t*)(F.ws + WS_A), (const pg8::bf16_t*)(F.ws + WS_B), MTOK, NPROJ_PAD, DM}; pg8::StaticOrder S; S.init(MTOK, NPROJ_PAD, F.G, F.bid);
        pg8::EpiProj E;
        E.QKV = (pg8::bf16_t*)(F.ws + WS_C); E.GB = (pg8::bf16_t*)(F.ws + WS_D);
        E.GZ = (float*)(F.ws + WS_GZ); E.outKp = F.out + O_KP; E.outKs = F.out + O_KS; E.outVp = F.out + O_VP; E.outVs = F.out + O_VS; E.rope = (const float*)(F.ws + WS_ROPE); E.pn0 = 0;
#ifdef GAPTEST
        { pg8::StaticOrder Sa = S; Sa.iend = 6; pg8::gemm_phase<pg8::EpiProj, pg8::StaticOrder, true, true>(glds, g, Sa, E, F.wave * 64 + lane_id_v());
          const unsigned long long t0 = __builtin_amdgcn_s_memrealtime(); while (__builtin_amdgcn_s_memrealtime() - t0 < (unsigned long long)GAPTEST * 100ull) __builtin_amdgcn_s_sleep(32);
          pg8::StaticOrder Sb = S; Sb.ibeg = 6; pg8::gemm_phase<pg8::EpiProj, pg8::StaticOrder, true, true>(glds, g, Sb, E, F.wave * 64 + lane_id_v()); }
#else
        pg8::gemm_phase<pg8::EpiProj, pg8::StaticOrder, true, true>(glds, g, S, E, F.wave * 64 + lane_id_v());
#endif
        if (REP(1)) pg8::gemm_phase<pg8::EpiProj, pg8::StaticOrder, true, true>(glds, g, S, E, F.wave * 64 + lane_id_v());
#ifdef REPSUB_PN0
        { pg8::Gemm g2{(const pg8::bf16_t*)(F.ws + WS_A), (const pg8::bf16_t*)(F.ws + WS_B) + (size_t)REPSUB_PN0 * 256 * DM, TP, REPSUB_NT * 256, DM}; pg8::StaticOrder S2; S2.init(TP, REPSUB_NT * 256, F.G, F.bid);
          pg8::EpiProj E2 = E; E2.pn0 = REPSUB_PN0;
          pg8::gemm_phase<pg8::EpiProj, pg8::StaticOrder, true, true>(glds, g2, S2, E2, F.wave * 64 + lane_id_v()); }
#endif
        if ((long)12 * F.G + F.bid >= (long)(MTOK / 256) * (NPROJ_PAD / 256)) cvt_cache_drain(F, 2);
        SEAM(1);
    }
    if (IN(2)) { cvt_cache_drain(F, 144); p2_gla_prep(F); if (REP(2)) p2_gla_prep(F); SEAM(2); }
    if (IN(3)) { p3_attn_scan(F); SEAM(3); }
    if (IN(5)) {
        pg8::Gemm g{(const pg8::bf16_t*)(F.ws + WS_F), (const pg8::bf16_t*)(F.ws + WS_WOUT), MTOK, DM, DM}; pg8::StaticOrder S; S.init(MTOK, DM, F.G, F.bid);
        pg8::EpiMix E{F.x_p, F.x_s, (pg8::bf16_t*)(F.ws + WS_A), ALPHA_RES};
        pg8::gemm_phase<pg8::EpiMix, pg8::StaticOrder, true, true>(glds, g, S, E, F.wave * 64 + lane_id_v());
        if (REP(5)) pg8::gemm_phase<pg8::EpiMix, pg8::StaticOrder, true, true>(glds, g, S, E, F.wave * 64 + lane_id_v());
        if ((long)4 * F.G + F.bid >= (long)(MTOK / 256) * (DM / 256)) cvt_tables_drain(F, 3);
        SEAM(5);
    }
    if (IN(6)) { if (REP(6)) p5_ln1(F, true); p5_ln1(F, false); SEAM(6); }
    if (IN(7)) {
        pg8::Gemm g{(const pg8::bf16_t*)(F.ws + WS_A), (const pg8::bf16_t*)(F.ws + WS_WQ), MTOK, 2048, DM}; pg8::StaticOrder S; S.init(MTOK, 2048, F.G, F.bid);
        pg8::EpiBf16<0> E{(pg8::bf16_t*)(F.ws + WS_B), 2048, nullptr, 0, 0, 1.f};
        pg8::gemm_phase<pg8::EpiBf16<0>, pg8::StaticOrder, true, true>(glds, g, S, E, F.wave * 64 + lane_id_v());
        if (REP(7)) pg8::gemm_phase<pg8::EpiBf16<0>, pg8::StaticOrder, true, true>(glds, g, S, E, F.wave * 64 + lane_id_v());
        if ((long)2 * F.G + F.bid >= (long)(MTOK / 256) * (2048 / 256)) cvt_tables_drain(F, 3);
        SEAM(7);
    }
    if (IN(8)) { p7_peer_select(F); if (REP(8)) p7_peer_select(F); cvt_tables_drain(F, 512); SEAM(8); }
    if (IN(9)) { p8_peer_gather(F); }
#undef IN
#undef SEAM
}

extern "C" void kernel_launch(void* const* d_in, const int* in_sizes, int n_in, void* d_out, int out_size, void* d_ws, size_t ws_size, hipStream_t stream) {
    static int grid = 0;
    if (grid == 0) {
        if (n_in != 24 || ws_size < WS_END) { fprintf(stderr, "kernel_launch: need 24 inputs and >= %zu bytes of workspace; got %d, %zu\n", (size_t)WS_END, n_in, ws_size); grid = -1; return; }
        int dev = 0, cus = 0, per_cu = 0;
        if (hipGetDevice(&dev) != hipSuccess || hipDeviceGetAttribute(&cus, hipDeviceAttributeMultiprocessorCount, dev) != hipSuccess) { grid = -1; return; }
        if (hipFuncSetAttribute((const void*)fwd_kernel, hipFuncAttributeMaxDynamicSharedMemorySize, LDS_BYTES) != hipSuccess) { fprintf(stderr, "kernel_launch: hipFuncSetAttribute failed\n"); grid = -1; return; }
        if (hipOccupancyMaxActiveBlocksPerMultiprocessor(&per_cu, (const void*)fwd_kernel, NWAVES * 64, LDS_BYTES) != hipSuccess || per_cu < 1) { fprintf(stderr, "kernel_launch: occupancy query says %d\n", per_cu); }
        (void)hipGetLastError();
        if (cus < 256) { fprintf(stderr, "kernel_launch: built for a 256-CU device (MI355X); this one reports %d CUs\n", cus); grid = -1; return; }
        grid = 256;
    }
    if (grid < 0) return;
    (void)hipMemsetAsync((char*)d_ws + WS_CTL, 0, CTL_ZERO_BYTES, stream);
    Args a{};
    for (int i = 0; i < 24; ++i) a.in[i] = (const float*)d_in[i];
    a.out = (float*)d_out; a.ws = (unsigned char*)d_ws;
#if MK_N_LAUNCHES == 1
    a.ph_lo = 0; a.ph_hi = NPH;
    hipLaunchKernelGGL(fwd_kernel, dim3(grid), dim3(NWAVES * 64), LDS_BYTES, stream, a);
#else
    for (int p = 0; p < NPH; ++p) { a.ph_lo = p; a.ph_hi = p + 1; hipLaunchKernelGGL(fwd_kernel, dim3(grid), dim3(NWAVES * 64), LDS_BYTES, stream, a); }
#endif
    const hipError_t le = hipPeekAtLastError();
    if (le != hipSuccess) fprintf(stderr, "kernel_launch: launch failed: %s\n", hipGetErrorName(le));
}
```

```cpp
#include <hip/hip_runtime.h>
#include <cstdio>
#include <cstdint>
namespace pg8 {
#define PG8_LAS __attribute__((address_space(3)))
typedef unsigned short bf16_t;
typedef short bf16x8 __attribute__((ext_vector_type(8)));
typedef float f32x4 __attribute__((ext_vector_type(4)));
typedef unsigned u32x4 __attribute__((ext_vector_type(4)));
constexpr int BM = 256, BK = 64, HALF = 128, HTB = HALF * BK * 2  , STAGE_BYTES = 8 * HTB, NXCD = 8, WGM = 8;

__host__ __device__ __forceinline__ int lds_byte(int r, int c) { const int st = (r >> 4) * 2 + (c >> 5), rr = r & 15, cc = c & 31, ob = rr * 64 + cc * 2; return st * 1024 + (ob ^ (((ob >> 9) & 1) << 5)); }
__host__ __device__ __forceinline__ void stage_rc(int b, int& R, int& C) { const int st = b / 1024, sb = b % 1024, swz = sb ^ (((sb >> 9) & 1) << 5); R = (st >> 1) * 16 + swz / 64; C = (st & 1) * 32 + (swz % 64) / 2; }
__host__ __device__ __forceinline__ int perm32(int rho) { const int n = rho >> 4, i = rho & 15; return 8 * (i >> 2) + 4 * n + (i & 3); }

struct Unit { int pm, pn, mask; };
struct Gemm { const bf16_t* A; const bf16_t* Bt; int M, N, K; };

struct StaticOrder {
    int nM, nN, nwg, G, c, ibeg, iend;
    __host__ __device__ void init(int M, int N, int G_, int c_) { nM = M / BM; nN = N / BM; nwg = nM * nN; G = G_; c = c_; ibeg = 0; iend = 1 << 30; }
    __host__ __device__ bool next(int i, Unit& u) const {
        i += ibeg; if (i >= iend) return false;
        const long L = (long)i * G + c; if (L >= nwg) return false;
        int wgid = (int)L; { const int q = nwg / NXCD, r = nwg % NXCD, xcd = wgid % NXCD, off = wgid / NXCD; wgid = (xcd < r ? xcd * (q + 1) : r * (q + 1) + (xcd - r) * q) + off; }
        const int nig = WGM * nN, gid = wgid / nig, fm = gid * WGM, gsz = (nM - fm) < WGM ? (nM - fm) : WGM;
        u.pm = fm + ((wgid % nig) % gsz); u.pn = (wgid % nig) / gsz; u.mask = 15; return true;
    }
    __device__ __forceinline__ void a_ready(const Unit&) const {}
    __device__ __forceinline__ void done(const Unit&) const {}
};

__device__ __forceinline__ unsigned cvt_pk_bf16(float lo, float hi) { unsigned r; asm volatile("v_cvt_pk_bf16_f32 %0, %1, %2" : "=v"(r) : "v"(lo), "v"(hi)); return r; }
typedef float f32x2 __attribute__((ext_vector_type(2)));
__device__ __forceinline__ f32x2 gelu_pk(f32x2 v) {
    const f32x2 av = __builtin_elementwise_abs(v), d = av * 0.2316418882f + 1.0f;
    f32x2 t; t.x = __builtin_amdgcn_rcpf(d.x); t.y = __builtin_amdgcn_rcpf(d.y);
    f32x2 q = t * 0.5307027145f + (-0.7265760135f); q = q * t + 0.7107068705f; q = q * t + (-0.142248368f); q = q * t + 0.127414796f; q = q * t;
    const f32x2 s = (v * v) * (-0.72134752044f);
    f32x2 e; e.x = __builtin_amdgcn_exp2f(s.x); e.y = __builtin_amdgcn_exp2f(s.y);
    const f32x2 m = v * (q * e), r = v - m;
    f32x2 o; o.x = v.x < 0.f ? m.x : r.x; o.y = v.y < 0.f ? m.y : r.y; return o;
}

template <int ACT  > struct EpiBf16 {
    static constexpr bool PERM = true, AFTER_DRAIN = false; static_assert(ACT == 0 || ACT == 1, "EpiBf16: ACT is 0 (none) or 1 (gelu_pk)");
    bf16_t* O; int ldc; const float* bias; int split_cols; size_t split_stride; float scale0;
    __device__ __forceinline__ void operator()(const f32x4 (&acc)[2][2][4][2], const Unit& u, int wr, int wc, int fr, int fq) const {
        const int row0 = u.pm * BM + wr * 64 + fr; int colt = u.pn * BM; bf16_t* base = O;
        float sc = 1.f; if (split_cols) { const int t = colt / split_cols; base += (size_t)t * split_stride; colt -= t * split_cols; if (t == 0) sc = scale0; }
        const int col0 = colt + wc * 32 + 8 * fq, bcol0 = u.pn * BM + wc * 32 + 8 * fq;
        f32x4 bv[2][2];
#pragma unroll
        for (int bj = 0; bj < 2; ++bj)
#pragma unroll
            for (int n = 0; n < 2; ++n) bv[bj][n] = bias ? *(const f32x4*)(bias + bcol0 + bj * HALF + 4 * n) : (f32x4){0.f, 0.f, 0.f, 0.f};
#pragma unroll
        for (int ai = 0; ai < 2; ++ai)
#pragma unroll
            for (int m = 0; m < 4; ++m) { bf16_t* rowp = base + (size_t)(row0 + ai * HALF + m * 16) * ldc + col0;
#pragma unroll
                for (int bj = 0; bj < 2; ++bj) { if (!((u.mask >> (2 * ai + bj)) & 1)) continue; f32x4 v0 = acc[ai][bj][m][0] + bv[bj][0], v1 = acc[ai][bj][m][1] + bv[bj][1];
                    if (ACT == 1) { f32x2 a = gelu_pk((f32x2){v0[0], v0[1]}), b = gelu_pk((f32x2){v0[2], v0[3]}), c = gelu_pk((f32x2){v1[0], v1[1]}), d = gelu_pk((f32x2){v1[2], v1[3]});
                        v0 = (f32x4){a.x, a.y, b.x, b.y}; v1 = (f32x4){c.x, c.y, d.x, d.y}; }
                    v0 = v0 * sc; v1 = v1 * sc; u32x4 w; w.x = cvt_pk_bf16(v0[0], v0[1]); w.y = cvt_pk_bf16(v0[2], v0[3]); w.z = cvt_pk_bf16(v1[0], v1[1]); w.w = cvt_pk_bf16(v1[2], v1[3]);
                    *(u32x4*)(rowp + bj * HALF) = w; } }
    }
};
typedef unsigned u32x2 __attribute__((ext_vector_type(2)));
struct EpiProj {
    static constexpr bool PERM = true, AFTER_DRAIN = false;
    bf16_t *QKV, *GB; float* GZ;
    float *outKp, *outKs, *outVp, *outVs; const float* rope; int pn0;
    __device__ __forceinline__ void operator()(const f32x4 (&acc)[2][2][4][2], const Unit& u, int wr, int wc, int fr, int fq) const {
        const int pn = u.pn + pn0; const int row0 = u.pm * BM + wr * 64 + fr;
        if (pn < 16) {
            const bool isk = pn >= 8; const int hb = (pn & 7) * 256, i0 = 16 * wc + 4 * fq;
            bf16_t* dstb = QKV + (isk ? (size_t)16640 * 2048 : (size_t)0);
#pragma unroll
            for (int ai = 0; ai < 2; ++ai) {
                f32x4 rr0[4], rr1[4];
#pragma unroll
                for (int m = 0; m < 4; ++m) { const int row = row0 + ai * HALF + m * 16; const int pos = row < 16384 ? (row & 8191) : 1024 + ((row - 16384) & 15);
                    const f32x4* rp = (const f32x4*)(rope + (size_t)pos * 128 + 2 * i0); rr0[m] = rp[0]; rr1[m] = rp[1]; }
#pragma unroll
                for (int m = 0; m < 4; ++m) {
                    const int row = row0 + ai * HALF + m * 16;
                    const f32x4 r0 = rr0[m], r1 = rr1[m];
                    float* okrow = row < 16384 ? outKp + (size_t)row * 2048 : outKs + (size_t)(row - 16384) * 2048;
#pragma unroll
                    for (int bj = 0; bj < 2; ++bj) { if (!((u.mask >> (2 * ai + bj)) & 1)) continue;
                        const f32x4 v0 = acc[ai][bj][m][0], v1 = acc[ai][bj][m][1];
                        f32x4 lo, hi;
                        lo[0] = v0[0] * r0[0] - v0[1] * r0[1]; hi[0] = v0[1] * r0[0] + v0[0] * r0[1];
                        lo[1] = v0[2] * r0[2] - v0[3] * r0[3]; hi[1] = v0[3] * r0[2] + v0[2] * r0[3];
                        lo[2] = v1[0] * r1[0] - v1[1] * r1[1]; hi[2] = v1[1] * r1[0] + v1[0] * r1[1];
                        lo[3] = v1[2] * r1[2] - v1[3] * r1[3]; hi[3] = v1[3] * r1[2] + v1[2] * r1[3];
                        const int col = hb + bj * HALF + i0;
                        u32x2 wl, wh; wl.x = cvt_pk_bf16(lo[0], lo[1]); wl.y = cvt_pk_bf16(lo[2], lo[3]); wh.x = cvt_pk_bf16(hi[0], hi[1]); wh.y = cvt_pk_bf16(hi[2], hi[3]);
                        *(u32x2*)(dstb + (size_t)row * 2048 + col) = wl; *(u32x2*)(dstb + (size_t)row * 2048 + col + 64) = wh;
                        if (isk) { __builtin_nontemporal_store(lo, (f32x4*)(okrow + col)); __builtin_nontemporal_store(hi, (f32x4*)(okrow + col + 64)); }
                    }
                }
            }
        } else if (pn < 24) {
            const int col0 = (pn - 16) * 256 + wc * 32 + 8 * fq;
#pragma unroll
            for (int ai = 0; ai < 2; ++ai)
#pragma unroll
                for (int m = 0; m < 4; ++m) {
                    const int row = row0 + ai * HALF + m * 16;
                    float* ovrow = row < 16384 ? outVp + (size_t)row * 2048 : outVs + (size_t)(row - 16384) * 2048;
#pragma unroll
                    for (int bj = 0; bj < 2; ++bj) { if (!((u.mask >> (2 * ai + bj)) & 1)) continue;
                        const f32x4 v0 = acc[ai][bj][m][0], v1 = acc[ai][bj][m][1]; const int col = col0 + bj * HALF;
                        __builtin_nontemporal_store(v0, (f32x4*)(ovrow + col)); __builtin_nontemporal_store(v1, (f32x4*)(ovrow + col + 4));
                        u32x4 w; w.x = cvt_pk_bf16(v0[0], v0[1]); w.y = cvt_pk_bf16(v0[2], v0[3]); w.z = cvt_pk_bf16(v1[0], v1[1]); w.w = cvt_pk_bf16(v1[2], v1[3]);
                        *(u32x4*)(QKV + (size_t)2 * 16640 * 2048 + (size_t)row * 2048 + col) = w;
                    }
                }
        } else if (pn < 48) {
            size_t eoff; int ld, colt;
            if (pn < 28) { eoff = 0; ld = 1024; colt = (pn - 24) * 256; }
            else if (pn < 32) { eoff = (size_t)16640 * 1024; ld = 1024; colt = (pn - 28) * 256; }
            else if (pn < 40) { eoff = (size_t)16640 * 2048; ld = 2048; colt = (pn - 32) * 256; }
            else { eoff = (size_t)16640 * 4096; ld = 2048; colt = (pn - 40) * 256; }
            bf16_t* base = GB + eoff;
            const int col0 = colt + wc * 32 + 8 * fq;
#pragma unroll
            for (int ai = 0; ai < 2; ++ai)
#pragma unroll
                for (int m = 0; m < 4; ++m) {
                    const int row = row0 + ai * HALF + m * 16;
#pragma unroll
                    for (int bj = 0; bj < 2; ++bj) { if (!((u.mask >> (2 * ai + bj)) & 1)) continue;
                        const f32x4 v0 = acc[ai][bj][m][0], v1 = acc[ai][bj][m][1];
                        u32x4 w; w.x = cvt_pk_bf16(v0[0], v0[1]); w.y = cvt_pk_bf16(v0[2], v0[3]); w.z = cvt_pk_bf16(v1[0], v1[1]); w.w = cvt_pk_bf16(v1[2], v1[3]);
                        *(u32x4*)(base + (size_t)row * ld + col0 + bj * HALF) = w;
                    }
                }
        } else {
            if (wc == 0 && fq < 2) {
#pragma unroll
                for (int ai = 0; ai < 2; ++ai)
#pragma unroll
                    for (int m = 0; m < 4; ++m) { if (!((u.mask >> (2 * ai)) & 1)) continue;
                        const int row = row0 + ai * HALF + m * 16;
                        *(f32x4*)(GZ + (size_t)row * 16 + 8 * fq) = acc[ai][0][m][0]; *(f32x4*)(GZ + (size_t)row * 16 + 8 * fq + 4) = acc[ai][0][m][1];
                    }
            }
        }
    }
};
struct EpiMix {
    static constexpr bool PERM = true, AFTER_DRAIN = false;
    const float* xp; const float* xs; bf16_t* O; float alpha;
    __device__ __forceinline__ void operator()(const f32x4 (&acc)[2][2][4][2], const Unit& u, int wr, int wc, int fr, int fq) const {
        const int row0 = u.pm * BM + wr * 64 + fr, col0 = u.pn * BM + wc * 32 + 8 * fq;
#pragma unroll
        for (int ai = 0; ai < 2; ++ai)
#pragma unroll
            for (int m = 0; m < 4; ++m) {
                const int row = row0 + ai * HALF + m * 16;
                const float* xr = (row < 16384 ? xp + (size_t)row * 4096 : xs + (size_t)(row - 16384) * 4096) + col0;
                bf16_t* orow = O + (size_t)row * 4096 + col0;
#pragma unroll
                for (int bj = 0; bj < 2; ++bj) { if (!((u.mask >> (2 * ai + bj)) & 1)) continue;
                    const f32x4 x0 = *(const f32x4*)(xr + bj * HALF), x1 = *(const f32x4*)(xr + bj * HALF + 4);
                    const f32x4 v0 = acc[ai][bj][m][0] + alpha * x0, v1 = acc[ai][bj][m][1] + alpha * x1;
                    u32x4 w; w.x = cvt_pk_bf16(v0[0], v0[1]); w.y = cvt_pk_bf16(v0[2], v0[3]); w.z = cvt_pk_bf16(v1[0], v1[1]); w.w = cvt_pk_bf16(v1[2], v1[3]);
                    *(u32x4*)(orow + bj * HALF) = w; }
            }
    }
};
template <class Epi, class Sched, bool ALIGN_EPI = false, bool SP2 = false>
__device__ __forceinline__ void gemm_phase(PG8_LAS unsigned char* lds, const Gemm g, const Sched& S, const Epi& E, int tid_in) {
    const int tid_ = tid_in;
    const int tid = tid_, wid = __builtin_amdgcn_readfirstlane(tid >> 6), lane = tid & 63, wr = wid >> 2, wc = wid & 3, fr = lane & 15, fq = lane >> 4;
    const int K = g.K, nt = K / BK;
    unsigned voffA[2], voffB[2];
#pragma unroll
    for (int i = 0; i < 2; ++i) { int R, C; stage_rc(tid * 16 + i * 8192, R, C); const int Rb = Epi::PERM ? ((R & ~31) + perm32(R & 31)) : R;
        voffA[i] = (unsigned)(R * K + C) * 2u; voffB[i] = (unsigned)(Rb * K + C) * 2u; }
    const size_t kstep = (size_t)(BK * 2);
    const size_t hstep = (size_t)HALF * K * 2;
    const size_t tstep = 2 * hstep;
    const unsigned ldsw = (unsigned)wid * 1024u;
    const int aoff = lds_byte(wr * 64 + fr, fq * 8), boff = lds_byte(wc * 32 + fr, fq * 8);
#define PG8_SA(b, h) (((b) * 2 + (h)) * HTB)
#define PG8_SB(b, h) ((4 + (b) * 2 + (h)) * HTB)
#define PG8_STAGE(bufoff, gbase, voff) do { _Pragma("unroll") for (int _i = 0; _i < 2; ++_i) \
        __builtin_amdgcn_global_load_lds((const unsigned*)((const char*)(gbase) + (voff)[_i]), (PG8_LAS unsigned*)(lds + (bufoff) + ldsw + _i * 8192), 16, 0, 0); } while (0)
#define PG8_LDA(dst, b, h) do { _Pragma("unroll") for (int m = 0; m < 4; ++m) _Pragma("unroll") for (int k = 0; k < 2; ++k) dst[m][k] = *(const PG8_LAS bf16x8*)(lds + PG8_SA(b, h) + aoff + m * 2048 + k * 1024); } while (0)
#define PG8_LDB(dst, b, h) do { _Pragma("unroll") for (int n = 0; n < 2; ++n) _Pragma("unroll") for (int k = 0; k < 2; ++k) dst[n][k] = *(const PG8_LAS bf16x8*)(lds + PG8_SB(b, h) + boff + n * 2048 + k * 1024); } while (0)
#define PG8_MMA(ai, bj, At, Bt) do { __builtin_amdgcn_s_setprio(1); _Pragma("unroll") for (int m = 0; m < 4; ++m) _Pragma("unroll") for (int n = 0; n < 2; ++n) _Pragma("unroll") for (int k = 0; k < 2; ++k) \
        acc[ai][bj][m][n] = __builtin_amdgcn_mfma_f32_16x16x32_bf16(Bt[n][k], At[m][k], acc[ai][bj][m][n], 0, 0, 0); __builtin_amdgcn_s_setprio(0); } while (0)
#define PG8_WAIT_V(n) asm volatile("s_waitcnt vmcnt(" #n ")" ::: "memory")
#define PG8_WAIT_L(n) asm volatile("s_waitcnt lgkmcnt(" #n ")" ::: "memory")
#define PG8_BAR __builtin_amdgcn_s_barrier()
#define PG8_SCHED __builtin_amdgcn_sched_barrier(0)
    Unit cur, nxt; int ui = 0;
    if (!S.next(0, cur)) return;
    f32x4 acc[2][2][4][2];
#pragma unroll
    for (int a = 0; a < 2; ++a)
#pragma unroll
        for (int b = 0; b < 2; ++b)
#pragma unroll
            for (int m = 0; m < 4; ++m)
#pragma unroll
                for (int n = 0; n < 2; ++n) acc[a][b][m][n] = (f32x4){0.f, 0.f, 0.f, 0.f};
    bf16x8 At[4][2], B0[2][2], B1[2][2];
    const char* cA = (const char*)g.A + (size_t)cur.pm * tstep; const char* cB = (const char*)g.Bt + (size_t)cur.pn * tstep;
    S.a_ready(cur);
    if constexpr (SP2) {
        PG8_STAGE(PG8_SB(0, 0), cB, voffB); PG8_STAGE(PG8_SB(0, 1), cB + hstep, voffB); PG8_STAGE(PG8_SA(0, 0), cA, voffA); PG8_STAGE(PG8_SA(0, 1), cA + hstep, voffA);
        if (wr == 1) PG8_BAR;
        PG8_WAIT_V(2); PG8_BAR;
        PG8_STAGE(PG8_SB(1, 0), cB + kstep, voffB); PG8_STAGE(PG8_SA(1, 0), cA + kstep, voffA); PG8_STAGE(PG8_SB(1, 1), cB + hstep + kstep, voffB);
        PG8_WAIT_V(6); PG8_BAR;
    } else {
        PG8_STAGE(PG8_SB(0, 0), cB, voffB); PG8_STAGE(PG8_SA(0, 0), cA, voffA); PG8_STAGE(PG8_SB(0, 1), cB + hstep, voffB); PG8_STAGE(PG8_SA(0, 1), cA + hstep, voffA);
        if (wr == 1) PG8_BAR;
        PG8_WAIT_V(4); PG8_BAR;
        PG8_STAGE(PG8_SB(1, 0), cB + kstep, voffB); PG8_STAGE(PG8_SA(1, 0), cA + kstep, voffA); PG8_STAGE(PG8_SB(1, 1), cB + hstep + kstep, voffB);
        PG8_WAIT_V(6); PG8_BAR;
    }
    for (;;) {
        const bool has_next = S.next(ui + 1, nxt);
        const char* nA = has_next ? (const char*)g.A + (size_t)nxt.pm * tstep : cA; const char* nB = has_next ? (const char*)g.Bt + (size_t)nxt.pn * tstep : cB;
        for (int t = 0; t < nt; t += 2) {
            const bool last = (t == nt - 2);
            const char* a1 = cA + (size_t)(t + 1) * kstep;
            const char* a2 = last ? nA : cA + (size_t)(t + 2) * kstep; const char* b2 = last ? nB : cB + (size_t)(t + 2) * kstep;
            const char* a3 = a2 + kstep; const char* b3 = b2 + kstep;
            if (last && has_next) S.a_ready(nxt);
            if constexpr (SP2) {
            PG8_LDB(B0, 0, 0); PG8_LDB(B1, 0, 1); PG8_SCHED; PG8_LDA(At, 0, 0); PG8_STAGE(PG8_SA(1, 1), a1 + hstep, voffA);
            PG8_WAIT_V(8); PG8_WAIT_L(0); PG8_BAR; PG8_MMA(0, 0, At, B0); PG8_MMA(0, 1, At, B1); PG8_BAR; PG8_SCHED;
            PG8_LDA(At, 0, 1); PG8_STAGE(PG8_SB(0, 0), b2, voffB); PG8_STAGE(PG8_SB(0, 1), b2 + hstep, voffB); PG8_STAGE(PG8_SA(0, 0), a2, voffA);
            PG8_WAIT_V(8); PG8_WAIT_L(0); PG8_BAR; PG8_MMA(1, 0, At, B0); PG8_MMA(1, 1, At, B1); PG8_BAR; PG8_SCHED;
            PG8_LDB(B0, 1, 0); PG8_LDB(B1, 1, 1); PG8_SCHED; PG8_LDA(At, 1, 0); PG8_STAGE(PG8_SA(0, 1), a2 + hstep, voffA);
            PG8_WAIT_V(8); PG8_WAIT_L(0); PG8_BAR; PG8_MMA(0, 0, At, B0); PG8_MMA(0, 1, At, B1); PG8_BAR; PG8_SCHED;
            PG8_LDA(At, 1, 1); PG8_STAGE(PG8_SB(1, 0), b3, voffB); PG8_STAGE(PG8_SB(1, 1), b3 + hstep, voffB); PG8_STAGE(PG8_SA(1, 0), a3, voffA);
            PG8_WAIT_V(8); PG8_WAIT_L(0); PG8_BAR; PG8_MMA(1, 0, At, B0); PG8_MMA(1, 1, At, B1); PG8_BAR; PG8_SCHED;
            } else {
            PG8_LDB(B0, 0, 0); PG8_SCHED; PG8_LDA(At, 0, 0); PG8_STAGE(PG8_SA(1, 1), a1 + hstep, voffA);
            PG8_WAIT_L(8); PG8_BAR; PG8_WAIT_L(0); PG8_MMA(0, 0, At, B0); PG8_BAR; PG8_SCHED;
            PG8_LDB(B1, 0, 1); PG8_STAGE(PG8_SB(0, 0), b2, voffB);
            PG8_BAR; PG8_WAIT_L(0); PG8_MMA(0, 1, At, B1); PG8_BAR;
            PG8_LDA(At, 0, 1); PG8_STAGE(PG8_SA(0, 0), a2, voffA);
            PG8_BAR; PG8_WAIT_L(0); PG8_MMA(1, 0, At, B0); PG8_BAR; PG8_SCHED;
            PG8_STAGE(PG8_SB(0, 1), b2 + hstep, voffB);
            PG8_WAIT_V(6); PG8_BAR; PG8_MMA(1, 1, At, B1); PG8_BAR;
            PG8_LDB(B0, 1, 0); PG8_SCHED; PG8_LDA(At, 1, 0); PG8_STAGE(PG8_SA(0, 1), a2 + hstep, voffA);
            PG8_WAIT_L(8); PG8_BAR; PG8_WAIT_L(0); PG8_MMA(0, 0, At, B0); PG8_BAR; PG8_SCHED;
            PG8_LDB(B1, 1, 1); PG8_STAGE(PG8_SB(1, 0), b3, voffB);
            PG8_BAR; PG8_WAIT_L(0); PG8_MMA(0, 1, At, B1); PG8_BAR;
            PG8_LDA(At, 1, 1); PG8_STAGE(PG8_SA(1, 0), a3, voffA);
            PG8_BAR; PG8_WAIT_L(0); PG8_MMA(1, 0, At, B0); PG8_BAR; PG8_SCHED;
            PG8_STAGE(PG8_SB(1, 1), b3 + hstep, voffB);
            PG8_WAIT_V(6); PG8_BAR; PG8_MMA(1, 1, At, B1); PG8_BAR;
            }
        }
        if constexpr (ALIGN_EPI) { if (wr == 0) PG8_BAR; }
        if constexpr (!Epi::AFTER_DRAIN) { E(acc, cur, wr, wc, fr, fq); S.done(cur); }
        if (!has_next) break;
#pragma unroll
        for (int a = 0; a < 2; ++a)
#pragma unroll
            for (int b = 0; b < 2; ++b)
#pragma unroll
                for (int m = 0; m < 4; ++m)
#pragma unroll
                    for (int n = 0; n < 2; ++n) acc[a][b][m][n] = (f32x4){0.f, 0.f, 0.f, 0.f};
        cur = nxt; cA = nA; cB = nB; ++ui;
        if constexpr (ALIGN_EPI) { if (wr == 1) PG8_BAR; }
    }
    PG8_WAIT_V(0);
    if constexpr (!ALIGN_EPI) { if (wr == 0) PG8_BAR; }
    PG8_BAR;
    if constexpr (Epi::AFTER_DRAIN) { E.fused(acc, cur, wr, wc, fr, fq, lds, wid, lane); S.done(cur); }
#undef PG8_SA
#undef PG8_SB
#undef PG8_STAGE
#undef PG8_LDA
#undef PG8_LDB
#undef PG8_MMA
#undef PG8_WAIT_V
#undef PG8_WAIT_L
#undef PG8_BAR
#undef PG8_SCHED
}
}
constexpr int DM = 4096, SEQ = 8192, TP = 16384, TSM = 256, MTOK = 16640;
constexpr int NPROJ = 12304, NPROJ_PAD = 12544;
constexpr int NWAVES = 8;
constexpr float ALPHA_RES = 1.189207115002721f, LN_EPS = 1e-5f, LAM_INIT = 0.2f;
constexpr size_t MiB = 1u << 20;
constexpr size_t WS_CTL = 0, CTL_ZERO_BYTES = 1 * MiB;
constexpr size_t WS_ROPE = 1 * MiB;
constexpr size_t WS_KEYB = 5 * MiB;
constexpr size_t WS_GZ   = 6 * MiB;
constexpr size_t WS_IDX  = 8 * MiB;
constexpr size_t WS_GATE = 17 * MiB;
constexpr size_t WS_WOUT = 26 * MiB;
constexpr size_t WS_WQ   = 58 * MiB;
constexpr size_t WS_A    = 74 * MiB;
constexpr size_t WS_B    = 204 * MiB;
constexpr size_t WS_QIN  = WS_B, WS_KENDT = WS_B + 32 * MiB, WS_AM = WS_B + 64 * MiB, WS_DEC = WS_B + 72 * MiB;
constexpr size_t WS_C    = 302 * MiB;
constexpr size_t WS_D    = 497 * MiB;
constexpr size_t WS_E    = 692 * MiB;
constexpr size_t WS_F    = 756 * MiB;
constexpr size_t WS_G    = 886 * MiB;
constexpr size_t WS_H    = 1146 * MiB;
constexpr size_t WS_END  = 1290 * MiB;
constexpr size_t SZ_TOK2048 = (size_t)MTOK * 2048 * 2;
constexpr int CW_TMO = 0, CW_QUEUE = 64, CW_BAR = 4096;
constexpr int LDS_BYTES = 163840, MISC_OFF = 159744;
constexpr size_t O_Y = 0, O_KP = 68157440, O_VP = 101711872, O_GP = 135266304, O_KS = 136314880, O_VS = 136839168, O_GS = 137363456;

#define GAS __attribute__((address_space(1)))
#define LAS __attribute__((address_space(3)))
typedef unsigned short bf16;
typedef unsigned v4u __attribute__((ext_vector_type(4)));
typedef unsigned v2u __attribute__((ext_vector_type(2)));
typedef float f32x4 __attribute__((ext_vector_type(4)));
typedef float f32x2 __attribute__((ext_vector_type(2)));
typedef float f32x16 __attribute__((ext_vector_type(16)));
typedef short bf16x8 __attribute__((ext_vector_type(8)));
typedef short s16x4 __attribute__((ext_vector_type(4)));
typedef __bf16 bf16x2_t __attribute__((ext_vector_type(2)));
typedef GAS unsigned gu32;
#define RLX_AGENT __ATOMIC_RELAXED, __HIP_MEMORY_SCOPE_AGENT
#define LDS_WAIT() asm volatile("s_waitcnt lgkmcnt(0)" ::: "memory")
#define VM_WAIT() asm volatile("s_waitcnt vmcnt(0)" ::: "memory")
__device__ __forceinline__ unsigned f2bf(float f) { unsigned u = __builtin_bit_cast(unsigned, f); return (u + 0x7fffu + ((u >> 16) & 1u)) >> 16; }
__device__ __forceinline__ unsigned pk2(float lo, float hi) { return f2bf(lo) | (f2bf(hi) << 16); }
__device__ __forceinline__ float bf2f(unsigned short b) { return __builtin_bit_cast(float, (unsigned)b << 16); }
__device__ __forceinline__ float bflo(unsigned w) { return __builtin_bit_cast(float, w << 16); }
__device__ __forceinline__ float bfhi(unsigned w) { return __builtin_bit_cast(float, w & 0xffff0000u); }
__device__ __forceinline__ int lane_id_v() { int l; asm volatile("v_mbcnt_lo_u32_b32 %0, -1, 0\n\tv_mbcnt_hi_u32_b32 %0, -1, %0" : "=v"(l)); return l; }
template <int CTRL> __device__ __forceinline__ float dppf(float v) { return __builtin_bit_cast(float, __builtin_amdgcn_update_dpp(0, __builtin_bit_cast(int, v), CTRL, 0xF, 0xF, true)); }
__device__ __forceinline__ float xor1(float v) { return dppf<0xB1>(v); }
__device__ __forceinline__ float xor2(float v) { return dppf<0x4E>(v); }
__device__ __forceinline__ float xor4s(float v) { return dppf<0x141>(v); }
__device__ __forceinline__ float xor8(float v) { return dppf<0x128>(v); }
__device__ __forceinline__ float xor16(float v) { return __builtin_bit_cast(float, __builtin_amdgcn_ds_swizzle(__builtin_bit_cast(int, v), 0x401F)); }
__device__ __forceinline__ float wave_sum(float v) {
    v += xor1(v); v += xor2(v); v += xor4s(v); v += xor8(v); v += xor16(v);
    const auto rr = __builtin_amdgcn_permlane32_swap(__float_as_uint(v), __float_as_uint(v), false, false); return __uint_as_float(rr[0]) + __uint_as_float(rr[1]);
}
__device__ __forceinline__ int crow(int r, int hi) { return (r & 3) + 8 * (r >> 2) + 4 * hi; }
#define MFMA32(a, b, c) __builtin_amdgcn_mfma_f32_32x32x16_bf16((a), (b), (c), 0, 0, 0)
#define XB_TMO      128
#define XB_XCNT(j)  (256  + 64 * (j))
#define XB_XSUB(j)  (1280 + 64 * (j))
#define XB_XGEN(j)  (2304 + 64 * (j))
#define XB_TOP      3328
#define XB_TOPGEN   3392
#define XCD_BAR_WORDS 3456
#define XB_SPIN_CAP (1u << 18)

__device__ __forceinline__ unsigned xb_ld(unsigned* p)              { return __hip_atomic_load(p, __ATOMIC_RELAXED, __HIP_MEMORY_SCOPE_AGENT); }
__device__ __forceinline__ unsigned xb_add(unsigned* p, unsigned v) { return __hip_atomic_fetch_add(p, v, __ATOMIC_RELAXED, __HIP_MEMORY_SCOPE_AGENT); }
__device__ __forceinline__ unsigned xb_xcc_id() { return (unsigned)__builtin_amdgcn_s_getreg((3 << 11) | 20) & 0xFu; }
#define XB_SPIN(cond, bar) do { unsigned _sp = 0; while (cond) { __builtin_amdgcn_s_sleep(1); \
    if ((++_sp & 255u) == 0u) { if (xb_ld(&(bar)[XB_TMO])) break; if (_sp > XB_SPIN_CAP) { atomicAdd(&(bar)[XB_TMO], 1u); break; } } } } while (0)

struct XcdBarrier {
    unsigned* bar; unsigned x; unsigned wv;
    volatile LAS unsigned* st;
};

__device__ __forceinline__ XcdBarrier xcd_barrier_post(unsigned* bar, volatile LAS unsigned* st) {
    XcdBarrier b; b.bar = bar; b.x = xb_xcc_id(); b.st = st;
    if (threadIdx.x == 0) (void)xb_add(&bar[XB_XCNT(b.x)], 1u);
    b.wv = (unsigned)__builtin_amdgcn_readfirstlane((int)(threadIdx.x >> 6));
    return b;
}
__device__ __forceinline__ void xcd_barrier_complete(unsigned* bar, unsigned x, unsigned& nloc, unsigned& nx) {
    const unsigned G = gridDim.x * gridDim.y * gridDim.z;
    unsigned sum, cnt, mine, sp = 0u;
    for (;;) {
        sum = 0u; cnt = 0u; mine = 0u;
#pragma unroll
        for (unsigned j = 0; j < 16; ++j) { const unsigned c = xb_ld(&bar[XB_XCNT(j)]); sum += c; cnt += (c > 0u) ? 1u : 0u; mine = (j == x) ? c : mine; }
        if (sum == G) break;
        __builtin_amdgcn_s_sleep(1);
        if ((++sp & 255u) == 0u) { if (xb_ld(&bar[XB_TMO])) break; if (sp > XB_SPIN_CAP) { atomicAdd(&bar[XB_TMO], 1u); break; } }
    }
    nloc = mine > 0u ? mine : 1u; nx = cnt > 0u ? cnt : 1u;
}

__device__ __forceinline__ void xcd_barrier(const XcdBarrier& b) {
    asm volatile("s_waitcnt vmcnt(0)" ::: "memory");
    __syncthreads();
    if (b.wv == 0u && lane_id_v() == 0) {
        unsigned* bar = b.bar;
        __builtin_amdgcn_s_waitcnt(0);
        unsigned nloc = b.st[0], nx = b.st[1];
        if (nloc == 0u) { xcd_barrier_complete(bar, b.x, nloc, nx); b.st[0] = nloc; b.st[1] = nx; }
        const unsigned old = xb_add(&bar[XB_XSUB(b.x)], 1u);
        const unsigned gen = old / nloc;
        if (old + 1u == (gen + 1u) * nloc) {
            __builtin_amdgcn_fence(__ATOMIC_RELEASE, "agent");
            asm volatile("s_waitcnt vmcnt(0)" ::: "memory");
            const unsigned og = xb_add(&bar[XB_TOP], 1u);
            const unsigned tg = og / nx;
            if (og + 1u == (tg + 1u) * nx) xb_add(&bar[XB_TOPGEN], 1u);
            else XB_SPIN(xb_ld(&bar[XB_TOPGEN]) == tg, bar);
            __builtin_amdgcn_fence(__ATOMIC_ACQUIRE, "agent");
            xb_add(&bar[XB_XGEN(b.x)], 1u);
            asm volatile("s_waitcnt vmcnt(0)" ::: "memory");
        } else {
            XB_SPIN(xb_ld(&bar[XB_XGEN(b.x)]) == gen, bar);
            __builtin_amdgcn_fence(__ATOMIC_ACQUIRE, "agent");
            asm volatile("s_waitcnt vmcnt(0)" ::: "memory");
        }
    }
    __syncthreads();
}
struct Frame {
    unsigned char* lds;
    gu32* ctl;
    int wave, G, bid;
    unsigned char* ws; float* out;
    const float *x_p, *x_s, *cache_k, *cache_v, *state, *w_in, *w_gate2, *b_gate, *lq1, *lk1, *lq2, *lk2, *dng, *gng, *w_out, *ln1g, *ln1b, *ln2g, *ln2b, *peer_wq, *keys1, *keys2, *peer_u, *peer_v;
};

template <int MODE>
__device__ __forceinline__ void p0_transpose_item(const float* W, int K, int N, bf16* WT, float* scr, int kb, int nb, int lane) {
    const int k0 = 64 * kb, n0 = 64 * nb; const int nc = n0 + lane; const bool okc = nc < N;
    float v[64];
#pragma unroll
    for (int i = 0; i < 64; ++i) v[i] = okc ? W[(size_t)(k0 + i) * N + nc] : 0.f;
#pragma unroll
    for (int i = 0; i < 64; ++i) scr[i * 65 + lane] = v[i];
    LDS_WAIT(); asm volatile("" ::: "memory");
    const int c = lane & 7;
#pragma unroll
    for (int j = 0; j < 8; ++j) { const int n = (lane >> 3) + 8 * j; const float* s = scr + (8 * c) * 65 + n; const int gn = n0 + n;
        v4u o; o.x = pk2(s[0 * 65], s[1 * 65]); o.y = pk2(s[2 * 65], s[3 * 65]); o.z = pk2(s[4 * 65], s[5 * 65]); o.w = pk2(s[6 * 65], s[7 * 65]);
        int dr = gn;
        if (MODE == 1 && gn < 4096) { const int jj = gn & 127; dr = (gn & ~127) + (jj < 64 ? 2 * jj : 2 * (jj - 64) + 1); }
        if (gn < N) *(v4u*)(WT + (size_t)dr * K + k0 + 8 * c) = o; }
    LDS_WAIT(); asm volatile("" ::: "memory");
}
__device__ __forceinline__ void cvt8(const float* src, bf16* dst) {
    const f32x4 a = *(const f32x4*)src, b = *(const f32x4*)(src + 4);
    v4u o; o.x = pk2(a[0], a[1]); o.y = pk2(a[2], a[3]); o.z = pk2(b[0], b[1]); o.w = pk2(b[2], b[3]);
    *(v4u*)dst = o;
}
__device__ __forceinline__ void cvt_stream(const float* src, bf16* dst, size_t n8, size_t gt, size_t ngt) {
    size_t i = gt;
    for (; i + 3 * ngt < n8; i += 4 * ngt) {
        f32x4 a[4], b[4];
#pragma unroll
        for (int k = 0; k < 4; ++k) { a[k] = *(const f32x4*)(src + (i + k * ngt) * 8); b[k] = *(const f32x4*)(src + (i + k * ngt) * 8 + 4); }
#pragma unroll
        for (int k = 0; k < 4; ++k) { v4u o; o.x = pk2(a[k][0], a[k][1]); o.y = pk2(a[k][2], a[k][3]); o.z = pk2(b[k][0], b[k][1]); o.w = pk2(b[k][2], b[k][3]); *(v4u*)(dst + (i + k * ngt) * 8) = o; }
    }
    for (; i < n8; i += ngt) cvt8(src + i * 8, dst + i * 8);
}
__device__ __forceinline__ void cvt_cache_unit(Frame& F, int u) {
    bf16* KSB = (bf16*)(F.ws + WS_H); bf16* VSB = (bf16*)(F.ws + WS_H + 72 * MiB); const int tid = F.wave * 64 + lane_id_v();
    if (u < 128) { const int sb = u >> 3, r0 = 128 * (u & 7);
        const float* ck = F.cache_k + ((size_t)sb * 1024 + r0) * 2048; const float* cv = F.cache_v + ((size_t)sb * 1024 + r0) * 2048; const size_t d0 = ((size_t)sb * 1152 + r0) * 2048;
        for (int k = tid; k < 128 * 256; k += 512) { cvt8(ck + (size_t)k * 8, KSB + d0 + (size_t)k * 8); cvt8(cv + (size_t)k * 8, VSB + d0 + (size_t)k * 8); } }
    else { const int sb = u - 128; const size_t d0 = ((size_t)sb * 1152 + 1040) * 2048;
        for (int k = tid; k < 112 * 256; k += 512) { *(v4u*)(KSB + d0 + (size_t)k * 8) = (v4u){0u, 0u, 0u, 0u}; *(v4u*)(VSB + d0 + (size_t)k * 8) = (v4u){0u, 0u, 0u, 0u}; } }
}
__device__ __forceinline__ void cvt_cache_drain(Frame& F, int max_units) {
    volatile unsigned* slot = (volatile unsigned*)(F.lds + MISC_OFF + 64);
    for (int n = 0; n < max_units; ++n) {
        __syncthreads();
        if ((F.wave * 64 + lane_id_v()) == 0) *slot = __hip_atomic_fetch_add((unsigned*)(F.ctl + CW_QUEUE + 64 * 9), 1u, __ATOMIC_RELAXED, __HIP_MEMORY_SCOPE_AGENT);
        __syncthreads();
        const int u = __builtin_amdgcn_readfirstlane((int)*slot);
        if (u >= 144) break;
        cvt_cache_unit(F, u);
    }
}
__device__ __forceinline__ void p0_prologue(Frame& F) {
    float* scr = (float*)(F.lds + F.wave * 16640);
    const int gw = F.bid * NWAVES + F.wave, NGW = F.G * NWAVES;
    const size_t gt = (size_t)F.bid * 512 + (F.wave * 64 + lane_id_v()), ngt = (size_t)F.G * 512;
    bf16* XB = (bf16*)(F.ws + WS_A); bf16* WIN_T = (bf16*)(F.ws + WS_B); bf16* WOUT_T = (bf16*)(F.ws + WS_WOUT); bf16* WQ_T = (bf16*)(F.ws + WS_WQ);
    constexpr int I_IN = 64 * 193, I_OUT = 64 * 64, I_Q = 64 * 32;
    for (int it = gw; it < I_IN + I_OUT + I_Q; it += NGW) {
        int r = it;
        if (r < I_IN) { p0_transpose_item<1>(F.w_in, DM, NPROJ, WIN_T, scr, r / 193, r % 193, lane_id_v()); continue; } r -= I_IN;
        if (r < I_OUT) { p0_transpose_item<0>(F.w_out, DM, DM, WOUT_T, scr, r / 64, r % 64, lane_id_v()); continue; } r -= I_OUT;
        p0_transpose_item<0>(F.peer_wq, DM, 2048, WQ_T, scr, r / 32, r % 32, lane_id_v());
    }
    { const size_t n16 = (size_t)(NPROJ_PAD - NPROJ) * DM * 2 / 16; v4u* z = (v4u*)(WIN_T + (size_t)NPROJ * DM);
      for (size_t i = gt; i < n16; i += ngt) z[i] = (v4u){0u, 0u, 0u, 0u}; }
    cvt_stream(F.x_p, XB, (size_t)TP * DM / 8, gt, ngt);
    cvt_stream(F.x_s, XB + (size_t)TP * DM, (size_t)TSM * DM / 8, gt, ngt);
    cvt_stream(F.keys1, (bf16*)(F.ws + WS_KEYB), (size_t)8 * 128 * 128 / 8, gt, ngt);
    cvt_stream(F.keys2, (bf16*)(F.ws + WS_KEYB) + 8 * 128 * 128, (size_t)8 * 128 * 128 / 8, gt, ngt);
    { float* rope = (float*)(F.ws + WS_ROPE);
      for (size_t idx = gt; idx < (size_t)8192 * 64; idx += ngt) {
          const int pos = (int)(idx >> 6), i = (int)(idx & 63);
          double inv = 1.0;
          if (i & 1) inv *= 0.8659643233600653; if (i & 2) inv *= 0.7498942093324558; if (i & 4) inv *= 0.5623413251903491;
          if (i & 8) inv *= 0.31622776601683794; if (i & 16) inv *= 0.09999999999999999; if (i & 32) inv *= 0.009999999999999998;
          const float invf = (float)inv; const float angf = (float)pos * invf; const double a = (double)angf;
          const double n = __builtin_rint(a * 0.15915494309189535); const double rr = __builtin_fma(-n, 6.283185307179586, a);
          const double kq = __builtin_rint(rr * 0.6366197723675814); const double y = __builtin_fma(-kq, 1.5707963267948966, rr); const double y2 = y * y;
          double s = 1.0 / 6227020800.0;
          s = s * y2 - 1.0 / 39916800.0; s = s * y2 + 1.0 / 362880.0; s = s * y2 - 1.0 / 5040.0; s = s * y2 + 1.0 / 120.0; s = s * y2 - 1.0 / 6.0; s = s * y2 + 1.0; s = s * y;
          double c = -1.0 / 87178291200.0;
          c = c * y2 + 1.0 / 479001600.0; c = c * y2 - 1.0 / 3628800.0; c = c * y2 + 1.0 / 40320.0; c = c * y2 - 1.0 / 720.0; c = c * y2 + 1.0 / 24.0; c = c * y2 - 0.5; c = c * y2 + 1.0;
          const int q = ((int)kq) & 3; double cs, sn;
          if (q == 0) { sn = s; cs = c; } else if (q == 1) { sn = c; cs = -s; } else if (q == 2) { sn = -s; cs = -c; } else { sn = -c; cs = s; }
          rope[idx * 2] = (float)cs; rope[idx * 2 + 1] = (float)sn;
      } }
}
__device__ __forceinline__ float log_sigmoid_f(float z) { return fminf(z, 0.f) - __logf(1.f + __expf(-fabsf(z))); }
__device__ __forceinline__ int qin_slot(int ch) { const int c = ch & 15; return (ch & ~15) + ((c >= 4 && c < 12) ? (c ^ 12) : c); }
__device__ __forceinline__ void gla_prep_prompt(Frame& F, int item) {
    const int c = item & 127, h = (item >> 7) & 3, b = item >> 9; const int m0 = b * SEQ + 64 * c;
    float* bc = (float*)F.lds;
    bf16* qs = (bf16*)(F.lds + 65536);
    bf16* ks = (bf16*)(F.lds + 65536 + 33792);
    float* gzs = (float*)(F.lds + 65536 + 2 * 33792);
    const float* GZ = (const float*)(F.ws + WS_GZ);
    const bf16* GQ = (const bf16*)(F.ws + WS_D); const bf16* GK = (const bf16*)(F.ws + WS_D + SZ_TOK2048 / 2); const bf16* GV = (const bf16*)(F.ws + WS_D + SZ_TOK2048);
    bf16* QIN = (bf16*)(F.ws + WS_QIN) + (size_t)item * 64 * 256; bf16* KENDT = (bf16*)(F.ws + WS_KENDT) + (size_t)item * 256 * 64;
    bf16* AM = (bf16*)(F.ws + WS_AM) + (size_t)item * 4096; float* DEC = (float*)(F.ws + WS_DEC) + (size_t)item * 256; bf16* VT = (bf16*)(F.ws + WS_E) + (size_t)item * 512 * 64;
    const int t = (F.wave * 64 + lane_id_v()), ch = t & 255, th = t >> 8;
    v4u vpre[8];
#pragma unroll
    for (int i = 0; i < 8; ++i) { const int p = t + 512 * i, tok = p >> 6, c8 = p & 63; vpre[i] = *(const v4u*)(GV + (size_t)(m0 + tok) * 2048 + h * 512 + 8 * c8); }
    unsigned short qa[32], ka[32];
#pragma unroll
    for (int e = 0; e < 32; ++e) { const int tok = 32 * th + e; qa[e] = GQ[(size_t)(m0 + tok) * 1024 + h * 256 + ch]; ka[e] = GK[(size_t)(m0 + tok) * 1024 + h * 256 + ch]; }
    const float gz0 = GZ[(size_t)(m0 + (t >> 4)) * 16 + (t & 15)], gz1 = GZ[(size_t)(m0 + 32 + (t >> 4)) * 16 + (t & 15)];
    __syncthreads();
    gzs[t] = gz0; gzs[t + 512] = gz1;
    float wg[16];
#pragma unroll
    for (int k = 0; k < 16; ++k) wg[k] = F.w_gate2[k * 1024 + h * 256 + ch];
    const float bias = F.b_gate[h * 256 + ch];
    __syncthreads();
    float run = 0.f;
    for (int tt = 0; tt < 32; ++tt) { const int tok = 32 * th + tt; float z = bias;
        const f32x4 z0 = *(const f32x4*)(gzs + tok * 16), z1 = *(const f32x4*)(gzs + tok * 16 + 4), z2 = *(const f32x4*)(gzs + tok * 16 + 8), z3 = *(const f32x4*)(gzs + tok * 16 + 12);
#pragma unroll
        for (int k = 0; k < 4; ++k) { z = fmaf(z0[k], wg[k], z); z = fmaf(z1[k], wg[4 + k], z); z = fmaf(z2[k], wg[8 + k], z); z = fmaf(z3[k], wg[12 + k], z); }
        run += log_sigmoid_f(z) * 0.0625f; bc[tok * 256 + ch] = run; }
    __syncthreads();
    const float b31 = bc[31 * 256 + ch]; const float btot = b31 + bc[63 * 256 + ch]; const float offs = th ? b31 : 0.f;
#pragma unroll
    for (int j4 = 0; j4 < 4; ++j4) {
        unsigned short qv[8], kv[8];
#pragma unroll
        for (int e = 0; e < 8; ++e) { qv[e] = qa[8 * j4 + e]; kv[e] = ka[8 * j4 + e]; }
        unsigned kp[4];
#pragma unroll
        for (int e2 = 0; e2 < 4; ++e2) {
            float ke[2];
#pragma unroll
            for (int e = 0; e < 2; ++e) { const int tok = 32 * th + 8 * j4 + 2 * e2 + e; const float bb = bc[tok * 256 + ch] + offs;
                const float q = bf2f(qv[2 * e2 + e]), k = bf2f(kv[2 * e2 + e]);
                const float qin = q * __expf(bb) * 0.0625f, kin = k * __expf(-bb); ke[e] = k * __expf(btot - bb);
                const unsigned short qb = (unsigned short)f2bf(qin);
                qs[tok * 264 + ch] = qb; ks[tok * 264 + ch] = (unsigned short)f2bf(kin);
                { const int sl = qin_slot(ch); QIN[tok * 256 + ((((sl >> 3) ^ (tok & 31)) << 3) | (sl & 7))] = qb; } }
            kp[e2] = pk2(ke[0], ke[1]);
        }
        *(v4u*)(KENDT + ch * 64 + (((4 * th + j4) ^ ((ch >> 1) & 7)) << 3)) = (v4u){kp[0], kp[1], kp[2], kp[3]};
    }
    if (th == 0) DEC[ch] = __expf(btot);
    __syncthreads();
    if (F.wave < 4) {
        const int tt = F.wave >> 1, ss = F.wave & 1, r32 = lane_id_v() & 31, hi = lane_id_v() >> 5;
        f32x16 d = {};
        if (!(tt == 0 && ss == 1)) {
#pragma unroll
            for (int kk = 0; kk < 16; ++kk) {
                const bf16x8 a = *(const bf16x8*)(qs + (32 * tt + r32) * 264 + 16 * kk + 8 * hi);
                const bf16x8 bq = *(const bf16x8*)(ks + (32 * ss + r32) * 264 + 16 * kk + 8 * hi);
                d = MFMA32(a, bq, d);
            }
        }
#pragma unroll
        for (int r = 0; r < 16; ++r) { const int ta = 32 * tt + crow(r, hi), sa = 32 * ss + r32; AM[ta * 64 + ((((sa >> 3) ^ ((ta >> 1) & 7)) << 3) | (sa & 7))] = (unsigned short)f2bf(sa <= ta ? d[r] : 0.f); }
    }
    __syncthreads();
    bf16* vs = (bf16*)F.lds;
#pragma unroll
    for (int i = 0; i < 8; ++i) { const int p = t + 512 * i, tok = p >> 6, c8 = p & 63; *(v4u*)(vs + tok * 520 + 8 * c8) = vpre[i]; }
    __syncthreads();
    { const int dv = t;
#pragma unroll
      for (int g = 0; g < 8; ++g) { unsigned w[4];
#pragma unroll
          for (int j = 0; j < 4; ++j) w[j] = (unsigned)vs[(8 * g + 2 * j) * 520 + dv] | ((unsigned)vs[(8 * g + 2 * j + 1) * 520 + dv] << 16);
          *(v4u*)(VT + dv * 64 + 8 * g) = (v4u){w[0], w[1], w[2], w[3]}; } }
}
__device__ __forceinline__ void sample_kv_copy(Frame& F, int item) {
    const int h = item & 3, sb = item >> 2; const int m0 = TP + sb * 16; const int t = (F.wave * 64 + lane_id_v());
    { const bf16* KB = (const bf16*)(F.ws + WS_C + SZ_TOK2048); const bf16* VB = (const bf16*)(F.ws + WS_C + 2 * SZ_TOK2048);
      bf16* KSB = (bf16*)(F.ws + WS_H); bf16* VSB = (bf16*)(F.ws + WS_H + 72 * MiB);
      const int row = t >> 5, pc = t & 31;
#pragma unroll
      for (int hh = 0; hh < 2; ++hh) { const size_t src = (size_t)(m0 + row) * 2048 + (h + 4 * hh) * 256 + 8 * pc, dst = ((size_t)sb * 1152 + 1024 + row) * 2048 + (h + 4 * hh) * 256 + 8 * pc;
          *(v4u*)(KSB + dst) = *(const v4u*)(KB + src); *(v4u*)(VSB + dst) = *(const v4u*)(VB + src); } }
}
__device__ __forceinline__ void gla_sample_item(Frame& F, int item) {
    const int h = item & 3, sb = item >> 2; const int m0 = TP + sb * 16;
    float* qT = (float*)F.lds;
    float* kT = qT + 4096;
    float* kin = kT + 4096;
    float* qn = kin + 4096;
    float* Am = qn + 4096;
    float* dec = Am + 256;
    float* gzs = dec + 256;
    const float* GZ = (const float*)(F.ws + WS_GZ);
    const bf16* GQ = (const bf16*)(F.ws + WS_D); const bf16* GK = (const bf16*)(F.ws + WS_D + SZ_TOK2048 / 2); const bf16* GV = (const bf16*)(F.ws + WS_D + SZ_TOK2048);
    bf16* MIXIN = (bf16*)(F.ws + WS_F);
    const int t = (F.wave * 64 + lane_id_v());
    __syncthreads();
    if (t < 256) gzs[t] = GZ[(size_t)(m0 + (t >> 4)) * 16 + (t & 15)];
    __syncthreads();
    if (t < 256) {
        const int ch = t; float wg[16];
#pragma unroll
        for (int k = 0; k < 16; ++k) wg[k] = F.w_gate2[k * 1024 + h * 256 + ch];
        const float bias = F.b_gate[h * 256 + ch];
        float bb[16]; float run = 0.f;
#pragma unroll
        for (int tok = 0; tok < 16; ++tok) { float z = bias;
#pragma unroll
            for (int k = 0; k < 16; ++k) z = fmaf(gzs[tok * 16 + k], wg[k], z);
            run += log_sigmoid_f(z) * 0.0625f; bb[tok] = run; }
        const float btot = run;
#pragma unroll
        for (int tok = 0; tok < 16; ++tok) {
            const float q = bf2f(GQ[(size_t)(m0 + tok) * 1024 + h * 256 + ch]), k = bf2f(GK[(size_t)(m0 + tok) * 1024 + h * 256 + ch]);
            const float qi = q * __expf(bb[tok]) * 0.0625f;
            qT[ch * 16 + tok] = qi; qn[tok * 256 + ch] = qi; kin[tok * 256 + ch] = k * __expf(-bb[tok]); kT[ch * 16 + tok] = k * __expf(btot - bb[tok]); }
        dec[ch] = __expf(btot);
    }
    __syncthreads();
    if (t < 256) { const int ti = t >> 4, si = t & 15; float a = 0.f;
        if (si <= ti) { for (int chh = 0; chh < 256; ++chh) a = fmaf(qn[ti * 256 + chh], kin[si * 256 + chh], a); }
        Am[ti * 16 + si] = a; }
    __syncthreads();
    { const int dv = t; float v[16], o[16];
#pragma unroll
      for (int s = 0; s < 16; ++s) v[s] = bf2f(GV[(size_t)(m0 + s) * 2048 + h * 512 + dv]);
#pragma unroll
      for (int ti = 0; ti < 16; ++ti) { float a = 0.f;
#pragma unroll
          for (int s = 0; s < 16; ++s) a = fmaf(Am[ti * 16 + s], v[s], a);
          o[ti] = a; }
      const float* S0 = F.state + ((size_t)(sb * 4 + h) * 256) * 512 + dv; float* S1 = F.out + O_GS + ((size_t)(sb * 4 + h) * 256) * 512 + dv;
      for (int chh = 0; chh < 256; ++chh) {
          const float s0 = S0[(size_t)chh * 512];
          const f32x4* qp = (const f32x4*)(qT + chh * 16); const f32x4* kp = (const f32x4*)(kT + chh * 16);
          float sn = dec[chh] * s0;
#pragma unroll
          for (int j = 0; j < 4; ++j) { const f32x4 qv = qp[j], kv = kp[j];
#pragma unroll
              for (int e = 0; e < 4; ++e) { o[4 * j + e] = fmaf(qv[e], s0, o[4 * j + e]); sn = fmaf(kv[e], v[4 * j + e], sn); } }
          S1[(size_t)chh * 512] = sn;
      }
#pragma unroll
      for (int ti = 0; ti < 16; ++ti) MIXIN[(size_t)(m0 + ti) * 4096 + 2048 + h * 512 + dv] = (unsigned short)f2bf(o[ti]);
    }
}
__device__ __forceinline__ void p2_gla_prep(Frame& F) {
    for (int it = F.bid; it < 1024 + 64; it += F.G) { if (it < 1024) gla_prep_prompt(F, it); else sample_kv_copy(F, it - 1024); }
}
namespace att {
constexpr int D = 128, NW = 8, QBLK = 32, KVBLK = 64;
constexpr float SCALE = 0.088388347648318440f, THR = 8.f;
constexpr int LDQ = 2048, LDK = 2048, LDO = 1024;
constexpr size_t SHM_V = KVBLK * D * 2, SHM_K = KVBLK * D * 2, SHM_ATTN = 2 * SHM_V + 2 * SHM_K + NW * 64 * 4;
#define KSWZ(row, colB) ((row) * 256 + ((colB) ^ (((row) & 7) << 4)))
#define SBAR() __builtin_amdgcn_sched_barrier(0)
__device__ __forceinline__ unsigned cvtpk(float lo, float hi) { unsigned r; asm volatile("v_cvt_pk_bf16_f32 %0, %1, %2" : "=v"(r) : "v"(lo), "v"(hi)); return r; }
__device__ __forceinline__ void partialSM(f32x16& p0, f32x16& p1, float& m_reg, float& mn, float& alpha, int rem, int hi) {
  constexpr float C = SCALE * 1.4426950408889634f;
  if (rem < 64) {
#pragma unroll
    for (int r = 0; r < 16; ++r) { if (8 * (r >> 2) >= rem) p0[r] = -1e30f; if (32 + 8 * (r >> 2) >= rem) p1[r] = -1e30f; }
  }
  float pmax = p0[0];
#pragma unroll
  for (int r = 1; r < 16; ++r) pmax = fmaxf(pmax, p0[r]);
#pragma unroll
  for (int r = 0; r < 16; ++r) pmax = fmaxf(pmax, p1[r]);
  { auto rr = __builtin_amdgcn_permlane32_swap(__float_as_uint(pmax), __float_as_uint(pmax), false, false);
    pmax = fmaxf(__uint_as_float(rr[0]), __uint_as_float(rr[1])); }
  if (__builtin_expect(__all(pmax - m_reg <= THR / SCALE), 1)) { mn = m_reg; alpha = 1.f; }
  else { mn = fmaxf(m_reg, pmax); alpha = __builtin_amdgcn_exp2f((m_reg - mn) * C); m_reg = mn; }
  float mnC = -mn * C;
#pragma unroll
  for (int r = 0; r < 16; ++r) p0[r] = fmaf(p0[r], C, mnC);
#pragma unroll
  for (int r = 0; r < 16; ++r) p1[r] = fmaf(p1[r], C, mnC);
#pragma unroll
  for (int r = 0; r < 16; ++r) p0[r] = __builtin_amdgcn_exp2f(p0[r]);
}
__device__ __forceinline__ void finishSM(f32x16& p0, f32x16& p1, float alpha, float& l_reg, bf16x8& pa0, bf16x8& pa1, bf16x8& pa2, bf16x8& pa3) {
#pragma unroll
  for (int r = 0; r < 16; ++r) p1[r] = __builtin_amdgcn_exp2f(p1[r]);
  float ps = 0;
#pragma unroll
  for (int r = 0; r < 16; ++r) ps += p0[r];
#pragma unroll
  for (int r = 0; r < 16; ++r) ps += p1[r];
  { auto rr = __builtin_amdgcn_permlane32_swap(__float_as_uint(ps), __float_as_uint(ps), false, false);
    ps = __uint_as_float(rr[0]) + __uint_as_float(rr[1]); }
  l_reg = l_reg * alpha + ps;
#define PK4(P, BASE, OUT) do { unsigned a0 = cvtpk(P[BASE + 0], P[BASE + 1]), a1 = cvtpk(P[BASE + 2], P[BASE + 3]);   \
    unsigned b0 = cvtpk(P[BASE + 4], P[BASE + 5]), b1 = cvtpk(P[BASE + 6], P[BASE + 7]);                              \
    auto r0 = __builtin_amdgcn_permlane32_swap(a0, b0, false, false); auto r1 = __builtin_amdgcn_permlane32_swap(a1, b1, false, false); \
    v4u w = {r0[0], r1[0], r0[1], r1[1]}; OUT = *reinterpret_cast<bf16x8*>(&w); } while (0)
  PK4(p0, 0, pa0); PK4(p0, 8, pa1); PK4(p1, 0, pa2); PK4(p1, 8, pa3);
#undef PK4
}
__device__ __forceinline__ void qkt(f32x16& p0, f32x16& p1, const bf16* Ks, const bf16x8* qr, int r32, int hi) {
  p0 = f32x16{}; p1 = f32x16{};
#pragma unroll
  for (int d0 = 0; d0 < 8; ++d0) { int cb = (d0 * 16 + hi * 8) * 2;
    bf16x8 b0 = *reinterpret_cast<const bf16x8*>((const char*)Ks + KSWZ(r32, cb));
    bf16x8 b1 = *reinterpret_cast<const bf16x8*>((const char*)Ks + KSWZ(32 + r32, cb));
    p0 = __builtin_amdgcn_mfma_f32_32x32x16_bf16(b0, qr[d0], p0, 0, 0, 0);
    p1 = __builtin_amdgcn_mfma_f32_32x32x16_bf16(b1, qr[d0], p1, 0, 0, 0); }
}
__device__ __forceinline__ int v_st(int k, int c) { const int kk = (k & ~0xC) | ((k & 4) << 1) | ((k & 8) >> 1); return ((kk >> 3) * 4 + (c >> 5)) * 512 + ((kk & 7) * 32 + (c & 31)) * 2; }
__device__ __forceinline__ int v_rd_base(int lane) { return ((lane & 3) << 3) | (((lane >> 2) & 3) << 6) | (((lane >> 4) & 1) << 5) | (((lane >> 5) & 1) << 8); }
constexpr int v_rd_off(int d0, int ks, int half) { return d0 * 512 + ks * 4096 + half * 2048; }
template <int OFF> __device__ __forceinline__ s16x4 tr_read(int vb) {
  s16x4 r; asm volatile("ds_read_b64_tr_b16 %0, %1 offset:%2" : "=&v"(r) : "v"(vb), "i"(OFF) : "memory"); return r;
}
template <int D0> __device__ __forceinline__ void pv_one(f32x16& od, int vb, bf16x8 pa0, bf16x8 pa1, bf16x8 pa2, bf16x8 pa3) {
  const s16x4 l0 = tr_read<v_rd_off(D0, 0, 0)>(vb), h0 = tr_read<v_rd_off(D0, 0, 1)>(vb), l1 = tr_read<v_rd_off(D0, 1, 0)>(vb), h1 = tr_read<v_rd_off(D0, 1, 1)>(vb);
  const s16x4 l2 = tr_read<v_rd_off(D0, 2, 0)>(vb), h2 = tr_read<v_rd_off(D0, 2, 1)>(vb), l3 = tr_read<v_rd_off(D0, 3, 0)>(vb), h3 = tr_read<v_rd_off(D0, 3, 1)>(vb);
  asm volatile("s_waitcnt lgkmcnt(0)" ::: "memory"); SBAR();
#define PK(L, H) (bf16x8){L[0], L[1], L[2], L[3], H[0], H[1], H[2], H[3]}
  od = __builtin_amdgcn_mfma_f32_32x32x16_bf16(pa0, PK(l0, h0), od, 0, 0, 0);
  od = __builtin_amdgcn_mfma_f32_32x32x16_bf16(pa1, PK(l1, h1), od, 0, 0, 0);
  od = __builtin_amdgcn_mfma_f32_32x32x16_bf16(pa2, PK(l2, h2), od, 0, 0, 0);
  od = __builtin_amdgcn_mfma_f32_32x32x16_bf16(pa3, PK(l3, h3), od, 0, 0, 0);
#undef PK
}
__device__ __forceinline__ void pv_d0(f32x16* o, int vb, bf16x8 pa0, bf16x8 pa1, bf16x8 pa2, bf16x8 pa3) {
  pv_one<0>(o[0], vb, pa0, pa1, pa2, pa3); pv_one<1>(o[1], vb, pa0, pa1, pa2, pa3); pv_one<2>(o[2], vb, pa0, pa1, pa2, pa3); pv_one<3>(o[3], vb, pa0, pa1, pa2, pa3);
}
__device__ __forceinline__ void attn_body(const bf16* __restrict__ Qb, int nq, const bf16* __restrict__ Kh, const bf16* __restrict__ Vh, int kvalid, int NT, float* __restrict__ Ob, char* lds) {
  int tid_ = threadIdx.x; asm volatile("" : "+v"(tid_));
  const int tid = tid_, wid = __builtin_amdgcn_readfirstlane(tid >> 6), lane = tid & 63, r32 = lane & 31, hi = lane >> 5;
  bf16* V_lds = (bf16*)lds; bf16* K_lds = (bf16*)(lds + 2 * SHM_V);
  float* ws = (float*)(lds + 2 * SHM_V + 2 * SHM_K) + wid * 64; float* li_l = ws; float* al_l = ws + 32;
  float m_reg = -1e30f, l_reg = 0; f32x16 o[4] = {}; bf16x8 qr[8];
  { const bf16* Qw = Qb + (long)(wid * QBLK + r32) * LDQ + hi * 8;
#pragma unroll
    for (int d0 = 0; d0 < 8; ++d0) qr[d0] = *reinterpret_cast<const bf16x8*>(Qw + d0 * 16); }
  const int sr = tid >> 4, sc = (tid & 15) * 8, vst0 = v_st(sr, sc), vst1 = v_st(32 + sr, sc);
  const int vb0 = (int)(uintptr_t)V_lds + v_rd_base(lane);
  struct { bf16x8 vs0, vs1, ks0, ks1; } sr_[2];
#define SLOAD(i, k0) do { sr_[i].vs0 = *reinterpret_cast<const bf16x8*>(&Vh[(long)((k0) + sr) * LDK + sc]); sr_[i].vs1 = *reinterpret_cast<const bf16x8*>(&Vh[(long)((k0) + 32 + sr) * LDK + sc]); \
    sr_[i].ks0 = *reinterpret_cast<const bf16x8*>(&Kh[(long)((k0) + sr) * LDK + sc]); sr_[i].ks1 = *reinterpret_cast<const bf16x8*>(&Kh[(long)((k0) + 32 + sr) * LDK + sc]); } while (0)
#define SWRITE(b, i) do { *(bf16x8*)((char*)V_lds + (b) * SHM_V + vst0) = sr_[i].vs0;          \
    *(bf16x8*)((char*)V_lds + (b) * SHM_V + vst1) = sr_[i].vs1; int kc = sc * 2;               \
    *(bf16x8*)((char*)K_lds + (b) * SHM_K + KSWZ(sr, kc)) = sr_[i].ks0;                       \
    *(bf16x8*)((char*)K_lds + (b) * SHM_K + KSWZ(32 + sr, kc)) = sr_[i].ks1; } while (0)
#define SWAIT() asm volatile("s_waitcnt vmcnt(4)" ::: "memory")
#define RESC(a) do { if (__any((a) < 1.f)) { if (hi == 0) al_l[r32] = (a); asm volatile("s_waitcnt lgkmcnt(0)" ::: "memory"); \
    _Pragma("unroll") for (int d = 0; d < 4; ++d) _Pragma("unroll") for (int r = 0; r < 16; ++r) o[d][r] *= al_l[crow(r, hi)]; } } while (0)
  f32x16 pA0, pA1, pB0, pB1; float mnA, mnB, alA, alB; bf16x8 pa0, pa1, pa2, pa3;
  constexpr int SE = 0, SO = 1;
  SLOAD(SE, 0); asm volatile("s_waitcnt vmcnt(0)" ::: "memory"); SWRITE(0, SE); __syncthreads();
  qkt(pA0, pA1, K_lds, qr, r32, hi); partialSM(pA0, pA1, m_reg, mnA, alA, kvalid, hi);
  SLOAD(SO, KVBLK); if (2 < NT) SLOAD(SE, 2 * KVBLK);
  SWAIT(); SWRITE(1, SO); __syncthreads();
  for (int j = 1; j + 1 < NT; j += 2) {
    SBAR(); qkt(pB0, pB1, (bf16*)((char*)K_lds + SHM_K), qr, r32, hi);
    finishSM(pA0, pA1, alA, l_reg, pa0, pa1, pa2, pa3); SBAR();
    SLOAD(SO, (j + 2) * KVBLK); SBAR();
    pv_d0(o, vb0, pa0, pa1, pa2, pa3); partialSM(pB0, pB1, m_reg, mnB, alB, kvalid - 64 * j, hi);
    __syncthreads(); SWAIT(); SWRITE(0, SE);
    RESC(alB); __syncthreads();
    SBAR(); qkt(pA0, pA1, K_lds, qr, r32, hi);
    finishSM(pB0, pB1, alB, l_reg, pa0, pa1, pa2, pa3); SBAR();
    if (j + 3 < NT) SLOAD(SE, (j + 3) * KVBLK); SBAR();
    pv_d0(o, vb0 + (int)SHM_V, pa0, pa1, pa2, pa3); partialSM(pA0, pA1, m_reg, mnA, alA, kvalid - 64 * (j + 1), hi);
    __syncthreads(); SWAIT(); SWRITE(1, SO);
    RESC(alA); __syncthreads();
  }
  SBAR(); qkt(pB0, pB1, (bf16*)((char*)K_lds + SHM_K), qr, r32, hi);
  finishSM(pA0, pA1, alA, l_reg, pa0, pa1, pa2, pa3); SBAR();
  pv_d0(o, vb0, pa0, pa1, pa2, pa3); partialSM(pB0, pB1, m_reg, mnB, alB, kvalid - 64 * (NT - 1), hi);
  __syncthreads(); RESC(alB);
  finishSM(pB0, pB1, alB, l_reg, pa0, pa1, pa2, pa3); SBAR();
  pv_d0(o, vb0 + (int)SHM_V, pa0, pa1, pa2, pa3);
  if (hi == 0) li_l[r32] = l_reg; asm volatile("s_waitcnt lgkmcnt(0)" ::: "memory");
  float rli[16];
#pragma unroll
  for (int r = 0; r < 16; ++r) rli[r] = __builtin_amdgcn_rcpf(li_l[crow(r, hi)]);
  float* Ow = Ob + (long)(wid * QBLK) * LDO;
#pragma unroll
  for (int r = 0; r < 16; ++r) { int orow = crow(r, hi);
    if (wid * QBLK + orow < nq) {
#pragma unroll
      for (int d0 = 0; d0 < 4; ++d0) Ow[(long)orow * LDO + d0 * 32 + r32] = o[d0][r] * rli[r]; } }
  __syncthreads();
#undef SLOAD
#undef SWRITE
#undef SWAIT
#undef RESC
}
}
namespace dat {
using namespace att;
__device__ __forceinline__ unsigned src_off(int p, int L) {
    const int reg = p >> 4, pp = p & 15; const int o = pp * 1024 + L * 16;
    if (reg < 2) { const int r = o >> 8, cc = (o >> 4) & 15; const int c = cc ^ (r & 7); return (unsigned)(r * LDK + reg * 128 + c * 8) * 2u; }
    const int st = o >> 9, w = o & 511; const int kk = ((st >> 2) << 3) | (w >> 6); const int c = ((st & 3) << 5) | ((w & 63) >> 1);
    const int k = (kk & ~0xC) | ((kk & 4) << 1) | ((kk & 8) >> 1);
    return (unsigned)(k * LDK + (reg - 2) * 128 + c) * 2u;
}
template <int D0> __device__ __forceinline__ void pv_one8(f32x16& od, int vb, bf16x8 pa0, bf16x8 pa1, bf16x8 pa2, bf16x8 pa3) {
  constexpr int HB = (D0 >> 2) * 16384, DD = D0 & 3;
  const s16x4 l0 = tr_read<HB + v_rd_off(DD, 0, 0)>(vb), h0 = tr_read<HB + v_rd_off(DD, 0, 1)>(vb), l1 = tr_read<HB + v_rd_off(DD, 1, 0)>(vb), h1 = tr_read<HB + v_rd_off(DD, 1, 1)>(vb);
  const s16x4 l2 = tr_read<HB + v_rd_off(DD, 2, 0)>(vb), h2 = tr_read<HB + v_rd_off(DD, 2, 1)>(vb), l3 = tr_read<HB + v_rd_off(DD, 3, 0)>(vb), h3 = tr_read<HB + v_rd_off(DD, 3, 1)>(vb);
  asm volatile("s_waitcnt lgkmcnt(0)" ::: "memory"); SBAR();
#define PK(L, H) (bf16x8){L[0], L[1], L[2], L[3], H[0], H[1], H[2], H[3]}
  od = __builtin_amdgcn_mfma_f32_32x32x16_bf16(pa0, PK(l0, h0), od, 0, 0, 0);
  od = __builtin_amdgcn_mfma_f32_32x32x16_bf16(pa1, PK(l1, h1), od, 0, 0, 0);
  od = __builtin_amdgcn_mfma_f32_32x32x16_bf16(pa2, PK(l2, h2), od, 0, 0, 0);
  od = __builtin_amdgcn_mfma_f32_32x32x16_bf16(pa3, PK(l3, h3), od, 0, 0, 0);
#undef PK
}
__device__ __forceinline__ void dattn_unit(const bf16* __restrict__ Qb, const bf16* __restrict__ Kh, const bf16* __restrict__ Vh, int nq, int kv_lo, int kv_hi, int NT,
                                           bf16* __restrict__ outp, const float* __restrict__ gnorm, float lam, unsigned char* lds, int tid_in) {
  const int tid_ = tid_in;
  const int tid = tid_, wid = __builtin_amdgcn_readfirstlane(tid >> 6), lane = tid & 63, r32 = lane & 31, hi = lane >> 5;
  const int br = wid >> 2, rg = wid & 3;
  const bool active = rg * 32 < nq;
  const int kvalid = rg < 2 ? kv_lo : kv_hi;
  float* wsf = (float*)(lds + 131072) + wid * 64; float* li_l = wsf; float* al_l = wsf + 32;
  float m_reg = -1e30f, l_reg = 0; f32x16 o[8];
#pragma unroll
  for (int d = 0; d < 8; ++d) o[d] = f32x16{};
  bf16x8 qr[8];
  { const bf16* Qw = Qb + (long)(rg * 32 + r32) * 2048 + br * 128 + hi * 8;
#pragma unroll
    for (int d0 = 0; d0 < 8; ++d0) qr[d0] = *reinterpret_cast<const bf16x8*>(Qw + d0 * 16); }
#define DMA_TILE(t, buf) do { const char* kt = (const char*)Kh + (size_t)(t) * (64 * 2048 * 2); const char* vt = (const char*)Vh + (size_t)(t) * (64 * 2048 * 2); \
    _Pragma("unroll") for (int i = 0; i < 8; ++i) __builtin_amdgcn_global_load_lds((const unsigned*)((wid < 4 ? kt : vt) + src_off(wid * 8 + i, lane)), (LAS unsigned*)(lds + (buf) * 65536 + (wid * 8 + i) * 1024), 16, 0, 0); } while (0)
  DMA_TILE(0, 0);
  for (int t = 0; t < NT; ++t) {
    asm volatile("s_waitcnt vmcnt(0)" ::: "memory");
    __builtin_amdgcn_s_barrier();
    if (t + 1 < NT) DMA_TILE(t + 1, (t + 1) & 1);
    const int rem = kvalid - 64 * t;
    if (active && rem > 0) {
      const bf16* Ks = (const bf16*)(lds + (t & 1) * 65536 + br * 16384);
      const int vb = (int)(uintptr_t)(lds + (t & 1) * 65536 + 32768) + v_rd_base(lane);
      f32x16 p0, p1; float mn, al; bf16x8 pa0, pa1, pa2, pa3;
      p0 = f32x16{}; p1 = f32x16{};
#pragma unroll
      for (int d0 = 0; d0 < 8; ++d0) { const int cb = (d0 * 16 + hi * 8) * 2;
        const bf16x8 b0 = *reinterpret_cast<const bf16x8*>((const char*)Ks + KSWZ(r32, cb));
        const bf16x8 b1 = *reinterpret_cast<const bf16x8*>((const char*)Ks + KSWZ(32 + r32, cb));
        p0 = __builtin_amdgcn_mfma_f32_32x32x16_bf16(b0, qr[d0], p0, 0, 0, 0);
        p1 = __builtin_amdgcn_mfma_f32_32x32x16_bf16(b1, qr[d0], p1, 0, 0, 0);
        }
      partialSM(p0, p1, m_reg, mn, al, rem, hi);
      if (__any(al < 1.f)) { if (hi == 0) al_l[r32] = al; asm volatile("s_waitcnt lgkmcnt(0)" ::: "memory");
#pragma unroll
        for (int d = 0; d < 8; ++d)
#pragma unroll
          for (int r = 0; r < 16; ++r) o[d][r] *= al_l[crow(r, hi)]; }
      finishSM(p0, p1, al, l_reg, pa0, pa1, pa2, pa3); SBAR();
      pv_one8<0>(o[0], vb, pa0, pa1, pa2, pa3); pv_one8<1>(o[1], vb, pa0, pa1, pa2, pa3); pv_one8<2>(o[2], vb, pa0, pa1, pa2, pa3); pv_one8<3>(o[3], vb, pa0, pa1, pa2, pa3);
      pv_one8<4>(o[4], vb, pa0, pa1, pa2, pa3); pv_one8<5>(o[5], vb, pa0, pa1, pa2, pa3); pv_one8<6>(o[6], vb, pa0, pa1, pa2, pa3); pv_one8<7>(o[7], vb, pa0, pa1, pa2, pa3);
    }
  }
#undef DMA_TILE
  if (hi == 0) li_l[r32] = l_reg; asm volatile("s_waitcnt lgkmcnt(0)" ::: "memory");
  float rli[16];
#pragma unroll
  for (int r = 0; r < 16; ++r) rli[r] = __builtin_amdgcn_rcpf(li_l[crow(r, hi)]);
  __builtin_amdgcn_s_barrier();
  float* ex = (float*)lds + (size_t)rg * 8192;
  if (br == 1) {
#pragma unroll
    for (int d = 0; d < 8; ++d)
#pragma unroll
      for (int r = 0; r < 16; ++r) ex[(d * 16 + r) * 64 + lane] = o[d][r] * rli[r] * lam;
  }
  asm volatile("s_waitcnt lgkmcnt(0)" ::: "memory"); __builtin_amdgcn_s_barrier(); asm volatile("" ::: "memory");
  if (br == 0 && active) {
    float ss[16];
#pragma unroll
    for (int r = 0; r < 16; ++r) ss[r] = 0.f;
#pragma unroll
    for (int d = 0; d < 8; ++d)
#pragma unroll
      for (int r = 0; r < 16; ++r) { const float v = o[d][r] * rli[r] - ex[(d * 16 + r) * 64 + lane]; o[d][r] = v; ss[r] = fmaf(v, v, ss[r]); }
#pragma unroll
    for (int r = 0; r < 16; ++r) { float v = ss[r]; v += xor1(v); v += xor2(v); v += xor4s(v); v += xor8(v); v += xor16(v);
        ss[r] = rsqrtf(v * (1.f / 256.f) + LN_EPS) * (1.f - LAM_INIT); }
#pragma unroll
    for (int d = 0; d < 8; ++d) { const float g = gnorm[32 * d + r32];
#pragma unroll
      for (int r = 0; r < 16; ++r) { const int rk = rg * 32 + (r & 3) + 8 * (r >> 2);
          if (rk + 4 * hi < nq) *(unsigned short*)((unsigned char*)outp + (size_t)rk * 8192 + 64 * d + (unsigned)(hi * (4 * 8192) + r32 * 2)) = (unsigned short)f2bf(o[d][r] * ss[r] * g); } }
  }
  asm volatile("s_waitcnt lgkmcnt(0)" ::: "memory"); __builtin_amdgcn_s_barrier(); asm volatile("" ::: "memory");
}
}
__device__ __forceinline__ unsigned cvt2(float lo, float hi) { const f32x2 v = {lo, hi}; return __builtin_bit_cast(unsigned, __builtin_convertvector(v, bf16x2_t)); }
__device__ __forceinline__ bf16x8 pack_acc(const f32x16& x, int s) {
    v4u p; p.x = cvt2(x[8 * s + 0], x[8 * s + 1]); p.y = cvt2(x[8 * s + 2], x[8 * s + 3]); p.z = cvt2(x[8 * s + 4], x[8 * s + 5]); p.w = cvt2(x[8 * s + 6], x[8 * s + 7]);
    return __builtin_bit_cast(bf16x8, p);
}
__device__ __forceinline__ void gla_scan_unit(Frame& F, int unit) {
    const int half = unit & 1, h = (unit >> 1) & 3, b = unit >> 3;
    int t_ = F.wave * 64 + lane_id_v();
    const int t = t_, lane = t & 63, r32 = t & 31, hi = (t >> 5) & 1; const int wave = F.wave;
    constexpr int STG = 74752;
    const int dvc = 256 * half + 32 * wave + r32;
    bf16* MIXIN = (bf16*)(F.ws + WS_F);
    f32x16 S[8];
#pragma unroll
    for (int i = 0; i < 8; ++i) S[i] = f32x16{};
    const int item0 = (b * 4 + h) * 128;
    const char* QINg = (const char*)(F.ws + WS_QIN) + (size_t)item0 * 32768; const char* KEg = (const char*)(F.ws + WS_KENDT) + (size_t)item0 * 32768;
    const char* AMg = (const char*)(F.ws + WS_AM) + (size_t)item0 * 8192; const char* DECg = (const char*)(F.ws + WS_DEC) + (size_t)item0 * 1024;
    const bf16* VTg = (const bf16*)(F.ws + WS_E) + (size_t)item0 * 512 * 64 + (size_t)dvc * 64 + 8 * hi;
#define SCAN_DMA(c, buf) do { for (int p = wave; p < 73; p += 8) { \
        const char* src = p < 32 ? QINg + (size_t)(c) * 32768 + p * 1024 : p < 64 ? KEg + (size_t)(c) * 32768 + (p - 32) * 1024 : p < 72 ? AMg + (size_t)(c) * 8192 + (p - 64) * 1024 : DECg + (size_t)(c) * 1024; \
        __builtin_amdgcn_global_load_lds((const unsigned*)(src + lane * 16), (LAS unsigned*)(F.lds + (buf) * STG + p * 1024), 16, 0, 0); } } while (0)
    __syncthreads();
    SCAN_DMA(0, 0);
    bf16x8 vt[4];
#pragma unroll
    for (int ks = 0; ks < 4; ++ks) vt[ks] = *(const bf16x8*)(VTg + 16 * ks);
    for (int c = 0; c < 128; ++c) {
        asm volatile("s_waitcnt vmcnt(0)" ::: "memory");
        __builtin_amdgcn_s_barrier(); asm volatile("" ::: "memory");
        bf16x8 vn[4];
#pragma unroll
        for (int ks = 0; ks < 4; ++ks) vn[ks] = vt[ks];
        if (c + 1 < 128) SCAN_DMA(c + 1, (c + 1) & 1);
        const unsigned char* sb = F.lds + (c & 1) * STG;
        const unsigned char* qsm = sb; const unsigned char* ksm = sb + 32768; const unsigned char* asm_ = sb + 65536; const float* dsm = (const float*)(sb + 73728);
        f32x16 o0 = f32x16{}, o1 = f32x16{};
#pragma unroll
        for (int dkt = 0; dkt < 8; ++dkt) {
#pragma unroll
            for (int s = 0; s < 2; ++s) {
                const bf16x8 xs = pack_acc(S[dkt], s);
                const int ch = 2 * (2 * dkt + s) + hi;
                const bf16x8 a0 = *(const bf16x8*)(qsm + r32 * 512 + ((ch ^ r32) << 4)), a1 = *(const bf16x8*)(qsm + (32 + r32) * 512 + ((ch ^ r32) << 4));
                o0 = MFMA32(a0, xs, o0); o1 = MFMA32(a1, xs, o1);
            }
            __builtin_amdgcn_sched_barrier(0);
        }
#pragma unroll
        for (int ks = 0; ks < 4; ++ks) { const int sw = ((2 * ks + hi) ^ ((r32 >> 1) & 7)) << 4;
            const bf16x8 a0 = *(const bf16x8*)(asm_ + r32 * 128 + sw), a1 = *(const bf16x8*)(asm_ + (32 + r32) * 128 + sw);
            o0 = MFMA32(a0, vt[ks], o0); o1 = MFMA32(a1, vt[ks], o1);
        }
        { unsigned char* rowbase = (unsigned char*)MIXIN + (((size_t)b * SEQ + 64 * c) * 4096 + 2048 + h * 512 + 256 * half + 32 * wave) * 2;
          const unsigned lane_off = (unsigned)(hi * (4 * 8192) + r32 * 2);
#pragma unroll
          for (int r = 0; r < 16; ++r) { const int rk = (r & 3) + 8 * (r >> 2);
              *(unsigned short*)(rowbase + (size_t)rk * 8192 + lane_off) = (unsigned short)f2bf(o0[r]); *(unsigned short*)(rowbase + (size_t)(rk + 32) * 8192 + lane_off) = (unsigned short)f2bf(o1[r]); } }
        if (c + 1 < 128) {
#pragma unroll
            for (int ks = 0; ks < 4; ++ks) vn[ks] = *(const bf16x8*)(VTg + (size_t)(c + 1) * 512 * 64 + 16 * ks); }
#pragma unroll
        for (int dkt = 0; dkt < 8; ++dkt) {
#pragma unroll
            for (int g4 = 0; g4 < 4; ++g4) { const f32x4 dv4 = *(const f32x4*)(dsm + 32 * dkt + 8 * g4 + 4 * hi);
#pragma unroll
                for (int e = 0; e < 4; ++e) S[dkt][4 * g4 + e] *= dv4[e]; }
#pragma unroll
            for (int ks = 0; ks < 4; ++ks) { const bf16x8 a = *(const bf16x8*)(ksm + (32 * dkt + r32) * 128 + (((2 * ks + hi) ^ ((r32 >> 1) & 7)) << 4)); S[dkt] = MFMA32(a, vt[ks], S[dkt]); }
            __builtin_amdgcn_sched_barrier(0);
        }
#pragma unroll
        for (int ks = 0; ks < 4; ++ks) vt[ks] = vn[ks];
    }
#undef SCAN_DMA
    float* SO = F.out + O_GP + ((size_t)(b * 4 + h) * 256) * 512 + dvc;
#pragma unroll
    for (int dkt = 0; dkt < 8; ++dkt)
#pragma unroll
        for (int r = 0; r < 16; ++r) SO[(size_t)(32 * dkt + crow(r, hi)) * 512] = S[dkt][r];
    asm volatile("s_waitcnt vmcnt(0) lgkmcnt(0)" ::: "memory"); __syncthreads();
}
__device__ __forceinline__ void cvt_tables_unit(Frame& F, int unit) {
    unsigned char* UQ = F.ws + WS_G; unsigned char* VQ = F.ws + WS_G + 64 * MiB;
    const size_t c0 = (size_t)unit * (32 * DM / 32);
    for (int k = (F.wave * 64 + lane_id_v()); k < 32 * DM / 32; k += 512) { const size_t c = c0 + k;
        f32x4 a[2][8];
#pragma unroll
        for (int tb = 0; tb < 2; ++tb) { const float* src = (tb ? F.peer_v : F.peer_u) + c * 32;
#pragma unroll
            for (int w = 0; w < 8; ++w) a[tb][w] = *(const f32x4*)(src + 4 * w); }
#pragma unroll
        for (int tb = 0; tb < 2; ++tb) { const float sc = tb ? 8.f : 192.f; v4u o;
#pragma unroll
            for (int w = 0; w < 4; ++w) { const f32x4 lo = a[tb][2 * w] * sc, hi = a[tb][2 * w + 1] * sc; unsigned pk = 0u;
                if (tb) { pk = __builtin_amdgcn_cvt_scalef32_pk_fp4_f32(pk, lo[0], lo[1], 1.0f, 0); pk = __builtin_amdgcn_cvt_scalef32_pk_fp4_f32(pk, lo[2], lo[3], 1.0f, 1);
                          pk = __builtin_amdgcn_cvt_scalef32_pk_fp4_f32(pk, hi[0], hi[1], 1.0f, 2); pk = __builtin_amdgcn_cvt_scalef32_pk_fp4_f32(pk, hi[2], hi[3], 1.0f, 3); }
                else {
#pragma unroll
                    for (int e = 0; e < 8; ++e) { const float t = e < 4 ? lo[e] : hi[e - 4]; pk |= ((unsigned)(int)__builtin_rintf(fminf(fmaxf(t, -8.f), 7.f)) & 0xfu) << (4 * e); } }
                o[w] = pk; }
            *(v4u*)((tb ? VQ : UQ) + c * 16) = o; } }
}
__device__ __forceinline__ void cvt_tables_drain(Frame& F, int max_units) {
    volatile unsigned* slot = (volatile unsigned*)(F.lds + MISC_OFF + 64);
    for (int n = 0; n < max_units; ++n) {
        __syncthreads();
        if ((F.wave * 64 + lane_id_v()) == 0) *slot = __hip_atomic_fetch_add((unsigned*)(F.ctl + CW_QUEUE + 64 * 8), 1u, __ATOMIC_RELAXED, __HIP_MEMORY_SCOPE_AGENT);
        __syncthreads();
        const int u = __builtin_amdgcn_readfirstlane((int)*slot);
        if (u >= 512) break;
        cvt_tables_unit(F, u);
    }
}
__device__ __forceinline__ void p3b_finalize(Frame& F, bool dummy, int gw, int NGW, int MEND) {
    const int lane = lane_id_v();
    bf16* MIXIN = (bf16*)(F.ws + WS_F); const bf16* GR = (const bf16*)(F.ws + WS_D + 2 * SZ_TOK2048);
    const f32x4 g0 = *(const f32x4*)(F.gng + 8 * lane), g1 = *(const f32x4*)(F.gng + 8 * lane + 4);
    v4u rawn[4], grn[4];
#pragma unroll
    for (int h = 0; h < 4; ++h) { rawn[h] = *(const v4u*)(MIXIN + (size_t)gw * 4096 + 2048 + h * 512 + 8 * lane); grn[h] = *(const v4u*)(GR + (size_t)gw * 2048 + h * 512 + 8 * lane); }
    for (int m = gw; m < MEND; m += NGW) {
        v4u raw[4], gr[4];
#pragma unroll
        for (int h = 0; h < 4; ++h) { raw[h] = rawn[h]; gr[h] = grn[h]; }
        if (m + NGW < MEND) {
#pragma unroll
            for (int h = 0; h < 4; ++h) { rawn[h] = *(const v4u*)(MIXIN + (size_t)(m + NGW) * 4096 + 2048 + h * 512 + 8 * lane); grn[h] = *(const v4u*)(GR + (size_t)(m + NGW) * 2048 + h * 512 + 8 * lane); } }
#pragma unroll
        for (int h = 0; h < 4; ++h) {
            const float x[8] = {bflo(raw[h].x), bfhi(raw[h].x), bflo(raw[h].y), bfhi(raw[h].y), bflo(raw[h].z), bfhi(raw[h].z), bflo(raw[h].w), bfhi(raw[h].w)};
            const float gg[8] = {bflo(gr[h].x), bfhi(gr[h].x), bflo(gr[h].y), bfhi(gr[h].y), bflo(gr[h].z), bfhi(gr[h].z), bflo(gr[h].w), bfhi(gr[h].w)};
            float ss = 0.f;
#pragma unroll
            for (int e = 0; e < 8; ++e) ss += x[e] * x[e];
            ss = wave_sum(ss); const float rs = rsqrtf(ss * (1.f / 512.f) + LN_EPS);
            float y[8];
#pragma unroll
            for (int e = 0; e < 8; ++e) { const float gn = e < 4 ? g0[e & 3] : g1[e & 3]; const float sl = gg[e] / (1.f + __expf(-gg[e])); y[e] = x[e] * rs * gn * sl; }
            bf16* p = (dummy ? (bf16*)(F.ws + WS_C) : MIXIN) + (size_t)m * 4096 + 2048 + h * 512 + 8 * lane;
            *(v4u*)p = (v4u){pk2(y[0], y[1]), pk2(y[2], y[3]), pk2(y[4], y[5]), pk2(y[6], y[7])};
        }
    }
}
__device__ __forceinline__ void p3_attn_scan(Frame& F) {
    volatile unsigned* slot = (volatile unsigned*)(F.lds + MISC_OFF + 64);
    const bf16* QB = (const bf16*)(F.ws + WS_C); const bf16* KB = (const bf16*)(F.ws + WS_C + SZ_TOK2048); const bf16* VB = (const bf16*)(F.ws + WS_C + 2 * SZ_TOK2048);
    const bf16* KSB = (const bf16*)(F.ws + WS_H); const bf16* VSB = (const bf16*)(F.ws + WS_H + 72 * MiB);
    bf16* MIXIN = (bf16*)(F.ws + WS_F);
    float lam;
    { const int lane = lane_id_v(); const float s1 = wave_sum(F.lq1[lane] * F.lk1[lane] + F.lq1[lane + 64] * F.lk1[lane + 64]);
      const float s2 = wave_sum(F.lq2[lane] * F.lk2[lane] + F.lq2[lane + 64] * F.lk2[lane + 64]);
      lam = expf(s1) - expf(s2) + LAM_INIT; }
    constexpr int QN = 2 + 8 + 128 + 16;
    bool fin_done = false;
    const int q0 = (int)(xb_xcc_id() & 7u);
    for (int dq = 0; dq < 8; ++dq) {
      const int q = (q0 + dq) & 7;
      for (;;) {
        __syncthreads();
        if ((F.wave * 64 + lane_id_v()) == 0) *slot = __hip_atomic_fetch_add((unsigned*)(F.ctl + CW_QUEUE + 64 * q), 1u, __ATOMIC_RELAXED, __HIP_MEMORY_SCOPE_AGENT);
        __syncthreads();
        const int u = __builtin_amdgcn_readfirstlane((int)*slot);
        if (u >= QN) break;
#ifndef NREP_S
#define NREP_S 1
#endif
        if (u < 10) {
            if (u < 2) { for (int rr = 0; rr < NREP_S; ++rr) gla_scan_unit(F, 2 * q + u); } else gla_sample_item(F, 8 * q + (u - 2));
            asm volatile("s_waitcnt vmcnt(0)" ::: "memory"); __syncthreads();
            if ((F.wave * 64 + lane_id_v()) == 0) { __builtin_amdgcn_fence(__ATOMIC_RELEASE, "agent"); asm volatile("s_waitcnt vmcnt(0)" ::: "memory");
                (void)__hip_atomic_fetch_add((unsigned*)(F.ctl + CW_QUEUE + 64 * 10), 1u, __ATOMIC_RELAXED, __HIP_MEMORY_SCOPE_AGENT); }
            continue; }
        int v = u - 10;
        const bf16 *Qp, *Kp, *Vp; bf16* Op; int nq, kv_lo, kv_hi, NT;
        if (v < 128) {
            const int a = v, jb = 63 - (a >> 1), pr = 2 * q + (a & 1), h = pr & 7, b = pr >> 3;
            const size_t row0 = (size_t)b * SEQ;
            Kp = KB + row0 * 2048 + h * 256; Vp = VB + row0 * 2048 + h * 256; Qp = QB + (row0 + 128 * jb) * 2048 + h * 256;
            Op = MIXIN + (row0 + 128 * jb) * 4096 + h * 256; nq = 128; kv_lo = 64 * (2 * jb + 1); kv_hi = 64 * (2 * jb + 2); NT = 2 * jb + 2;
        } else {
            v -= 128; const int h = v & 7, sb = 2 * q + (v >> 3);
            const size_t rowq = (size_t)TP + sb * 16;
            Kp = KSB + (size_t)sb * 1152 * 2048 + h * 256; Vp = VSB + (size_t)sb * 1152 * 2048 + h * 256; Qp = QB + rowq * 2048 + h * 256;
            Op = MIXIN + rowq * 4096 + h * 256; nq = 16; kv_lo = 1040; kv_hi = 1040; NT = 17;
        }
#ifndef NREP_A
#define NREP_A 1
#endif
        for (int rr = 0; rr < NREP_A; ++rr) dat::dattn_unit(Qp, Kp, Vp, nq, kv_lo, kv_hi, NT, Op, F.dng, lam, F.lds, F.wave * 64 + lane_id_v());
        if (!fin_done) {
            __syncthreads();
            if ((F.wave * 64 + lane_id_v()) == 0) { unsigned r = 0xffffffffu;
                if (__hip_atomic_load((unsigned*)(F.ctl + CW_QUEUE + 64 * 10), __ATOMIC_RELAXED, __HIP_MEMORY_SCOPE_AGENT) >= 80u) r = __hip_atomic_fetch_add((unsigned*)(F.ctl + CW_QUEUE + 64 * 11), 1u, __ATOMIC_RELAXED, __HIP_MEMORY_SCOPE_AGENT);
                *slot = r; }
            __syncthreads();
            const unsigned fu = (unsigned)__builtin_amdgcn_readfirstlane((int)*slot);
            if (fu != 0xffffffffu) {
                if (fu >= (unsigned)(MTOK / 64)) fin_done = true;
                else { __builtin_amdgcn_fence(__ATOMIC_ACQUIRE, "agent"); asm volatile("s_waitcnt vmcnt(0)" ::: "memory"); p3b_finalize(F, false, 64 * (int)fu + F.wave, 8, 64 * (int)fu + 64); }
            }
        }
      }
    }
    if ((F.wave * 64 + lane_id_v()) == 0) { unsigned sp = 0; while (__hip_atomic_load((unsigned*)(F.ctl + CW_QUEUE + 64 * 10), __ATOMIC_RELAXED, __HIP_MEMORY_SCOPE_AGENT) < 80u && ++sp < (1u << 22)) __builtin_amdgcn_s_sleep(8); }
    __syncthreads(); __builtin_amdgcn_fence(__ATOMIC_ACQUIRE, "agent"); asm volatile("s_waitcnt vmcnt(0)" ::: "memory");
    for (;;) {
        __syncthreads();
        if ((F.wave * 64 + lane_id_v()) == 0) *slot = __hip_atomic_fetch_add((unsigned*)(F.ctl + CW_QUEUE + 64 * 11), 1u, __ATOMIC_RELAXED, __HIP_MEMORY_SCOPE_AGENT);
        __syncthreads();
        const int u2 = __builtin_amdgcn_readfirstlane((int)*slot);
        if (u2 >= MTOK / 64) break;
        p3b_finalize(F, false, 64 * u2 + F.wave, 8, 64 * u2 + 64);
    }
}
__device__ __forceinline__ void p5_ln1(Frame& F, bool dummy) {
    const int gw = F.bid * NWAVES + F.wave, NGW = F.G * NWAVES, lane = lane_id_v();
    bf16* X1B = (bf16*)(F.ws + WS_A);
    v4u wn[8];
#pragma unroll
    for (int k = 0; k < 8; ++k) wn[k] = *(const v4u*)(X1B + (size_t)gw * DM + 8 * (lane + 64 * k));
    for (int m = gw; m < MTOK; m += NGW) {
        bf16* xr = X1B + (size_t)m * DM; float v[8][8]; float s = 0.f;
#pragma unroll
        for (int k = 0; k < 8; ++k) { const unsigned ww[4] = {wn[k].x, wn[k].y, wn[k].z, wn[k].w};
#pragma unroll
            for (int e = 0; e < 4; ++e) { v[k][2 * e] = __uint_as_float(ww[e] << 16); v[k][2 * e + 1] = __uint_as_float(ww[e] & 0xffff0000u); s += v[k][2 * e] + v[k][2 * e + 1]; } }
        if (m + NGW < MTOK) {
#pragma unroll
            for (int k = 0; k < 8; ++k) wn[k] = *(const v4u*)(xr + (size_t)NGW * DM + 8 * (lane + 64 * k)); }
        const float mean = wave_sum(s) * (1.f / DM); float s2 = 0.f;
#pragma unroll
        for (int k = 0; k < 8; ++k)
#pragma unroll
            for (int e = 0; e < 8; ++e) { v[k][e] -= mean; s2 += v[k][e] * v[k][e]; }
        const float rstd = rsqrtf(wave_sum(s2) * (1.f / DM) + LN_EPS);
#pragma unroll
        for (int k = 0; k < 8; ++k) { const int c = 8 * (lane + 64 * k);
            const f32x4 g0 = *(const f32x4*)(F.ln1g + c), g1 = *(const f32x4*)(F.ln1g + c + 4), b0 = *(const f32x4*)(F.ln1b + c), b1 = *(const f32x4*)(F.ln1b + c + 4);
            v4u w; w.x = pk2(v[k][0] * rstd * g0[0] + b0[0], v[k][1] * rstd * g0[1] + b0[1]); w.y = pk2(v[k][2] * rstd * g0[2] + b0[2], v[k][3] * rstd * g0[3] + b0[3]);
            w.z = pk2(v[k][4] * rstd * g1[0] + b1[0], v[k][5] * rstd * g1[1] + b1[1]); w.w = pk2(v[k][6] * rstd * g1[2] + b1[2], v[k][7] * rstd * g1[3] + b1[3]);
            *(v4u*)((dummy ? (bf16*)(F.ws + WS_E) + (size_t)(m & 4095) * DM : xr) + c) = w;
            if (!dummy) { unsigned qb[8];
#pragma unroll
                for (int e = 0; e < 8; ++e) { const float g = e < 4 ? g0[e] : g1[e - 4], bb = e < 4 ? b0[e] : b1[e - 4];
                    qb[e] = (unsigned)(int)__builtin_rintf(fminf(fmaxf((v[k][e] * rstd * g + bb) * 24.f, -127.f), 127.f)) & 0xffu; }
                v2u o8; o8.x = qb[0] | (qb[2] << 8) | (qb[4] << 16) | (qb[6] << 24); o8.y = qb[1] | (qb[3] << 8) | (qb[5] << 16) | (qb[7] << 24);
                *(v2u*)(F.ws + WS_C + (size_t)m * DM + c) = o8; } }
    }
}
__device__ __forceinline__ int mono(float f) { return __builtin_bit_cast(int, f); }
__device__ __forceinline__ float unmono(int s) { return __builtin_bit_cast(float, s); }
__device__ __forceinline__ int kmax(int a, int b) { int r; asm("v_max_f32 %0, %1, %2" : "=v"(r) : "v"(a), "v"(b)); return r; }
__device__ __forceinline__ int kmin(int a, int b) { int r; asm("v_min_f32 %0, %1, %2" : "=v"(r) : "v"(a), "v"(b)); return r; }
#define CE_DESC(A, i_, j_) do { const int a_ = A[i_], b_ = A[j_]; A[i_] = kmax(a_, b_); A[j_] = kmin(a_, b_); } while (0)
__device__ __forceinline__ void sort16_desc(int (&A)[16]) {
    CE_DESC(A, 0, 13); CE_DESC(A, 1, 12); CE_DESC(A, 2, 15); CE_DESC(A, 3, 14); CE_DESC(A, 4, 8); CE_DESC(A, 5, 6); CE_DESC(A, 7, 11); CE_DESC(A, 9, 10);
    CE_DESC(A, 0, 5); CE_DESC(A, 1, 7); CE_DESC(A, 2, 9); CE_DESC(A, 3, 4); CE_DESC(A, 6, 13); CE_DESC(A, 8, 14); CE_DESC(A, 10, 15); CE_DESC(A, 11, 12);
    CE_DESC(A, 0, 1); CE_DESC(A, 2, 3); CE_DESC(A, 4, 5); CE_DESC(A, 6, 8); CE_DESC(A, 7, 9); CE_DESC(A, 10, 11); CE_DESC(A, 12, 13); CE_DESC(A, 14, 15);
    CE_DESC(A, 0, 2); CE_DESC(A, 1, 3); CE_DESC(A, 4, 10); CE_DESC(A, 5, 11); CE_DESC(A, 6, 7); CE_DESC(A, 8, 9); CE_DESC(A, 12, 14); CE_DESC(A, 13, 15);
    CE_DESC(A, 1, 2); CE_DESC(A, 3, 12); CE_DESC(A, 4, 6); CE_DESC(A, 5, 7); CE_DESC(A, 8, 10); CE_DESC(A, 9, 11); CE_DESC(A, 13, 14);
    CE_DESC(A, 1, 4); CE_DESC(A, 2, 6); CE_DESC(A, 5, 8); CE_DESC(A, 7, 10); CE_DESC(A, 9, 13); CE_DESC(A, 11, 14);
    CE_DESC(A, 2, 4); CE_DESC(A, 3, 6); CE_DESC(A, 9, 12); CE_DESC(A, 11, 13);
    CE_DESC(A, 3, 5); CE_DESC(A, 6, 8); CE_DESC(A, 7, 9); CE_DESC(A, 10, 12);
    CE_DESC(A, 3, 4); CE_DESC(A, 5, 6); CE_DESC(A, 7, 8); CE_DESC(A, 9, 10); CE_DESC(A, 11, 12);
    CE_DESC(A, 6, 7); CE_DESC(A, 8, 9);
}
__device__ __forceinline__ void merge16_desc(int (&A)[16], const int (&B)[16]) {
#pragma unroll
    for (int q = 0; q < 16; ++q) A[q] = kmax(A[q], B[15 - q]);
#pragma unroll
    for (int dd = 8; dd >= 1; dd >>= 1)
#pragma unroll
        for (int q = 0; q < 16; ++q) if ((q & dd) == 0) CE_DESC(A, q, q + dd);
}
__device__ __forceinline__ void top16_of_128(const f32x16 (&sc)[4], int hi, int (&L)[16]) {
    int G[16];
#pragma unroll
    for (int kt = 0; kt < 4; ++kt) {
#pragma unroll
        for (int r = 0; r < 16; ++r) { const int key = 32 * kt + (r & 3) + 8 * (r >> 2) + 4 * hi; G[r] = (mono(sc[kt][r]) & ~127) | key; }
        sort16_desc(G);
        if (kt == 0) {
#pragma unroll
            for (int q = 0; q < 16; ++q) L[q] = G[q];
        } else merge16_desc(L, G);
        __builtin_amdgcn_sched_barrier(0);
    }
#pragma unroll
    for (int q = 0; q < 16; ++q) { const auto rr = __builtin_amdgcn_permlane32_swap((unsigned)L[q], (unsigned)L[q], false, false); G[q] = (int)(hi ? rr[0] : rr[1]); }
    merge16_desc(L, G);
}
__device__ __forceinline__ void p7_peer_select(Frame& F) {
    int t_ = F.wave * 64 + lane_id_v();
    const int tid = t_, lane = t_ & 63, r32 = lane & 31, hi = lane >> 5, wave = F.wave;
    const bf16* QP = (const bf16*)(F.ws + WS_B); const bf16* KEYB = (const bf16*)(F.ws + WS_KEYB);
    int* IDX = (int*)(F.ws + WS_IDX); float* GATE = (float*)(F.ws + WS_GATE);
    const int h = F.bid & 7, g = F.bid >> 3;
    unsigned char* ks = F.lds;
    __syncthreads();
    { v4u kv[8];
#pragma unroll
      for (int i = 0; i < 8; ++i) { const int k = tid + 512 * i; const int half = k >> 11, key = (k >> 4) & 127, pc = k & 15; kv[i] = *(const v4u*)(KEYB + ((size_t)(half * 8 + h) * 128 + key) * 128 + 8 * pc); }
#pragma unroll
      for (int i = 0; i < 8; ++i) { const int k = tid + 512 * i; const int half = k >> 11, key = (k >> 4) & 127, pc = k & 15; *(v4u*)(ks + (half * 128 + key) * 272 + 16 * pc) = kv[i]; } }
    __syncthreads();
    for (int kk = wave; g + 32 * kk < MTOK / 32; kk += 8) {
        const int tt = g + 32 * kk; const int tok = 32 * tt + r32;
        int T1[16], T2[16];
#pragma unroll
        for (int half = 0; half < 2; ++half) {
            f32x16 sc[4];
#pragma unroll
            for (int kt = 0; kt < 4; ++kt) sc[kt] = f32x16{};
            const char* qb = (const char*)(QP + (size_t)(32 * tt) * 2048 + h * 256 + half * 128);
            unsigned qoff = (unsigned)(r32 * 4096 + hi * 16); asm volatile("" : "+v"(qoff));
            bf16x8 bq[8];
#pragma unroll
            for (int s = 0; s < 8; ++s) bq[s] = *(const bf16x8*)(qb + 32 * s + qoff);
            const unsigned char* kb = ks + half * (128 * 272) + r32 * 272 + hi * 16;
#pragma unroll
            for (int s = 0; s < 8; ++s) {
#pragma unroll
                for (int kt = 0; kt < 4; ++kt) { const bf16x8 a = *(const bf16x8*)(kb + kt * (32 * 272) + 32 * s); sc[kt] = MFMA32(a, bq[s], sc[kt]); }
                if (s & 1) __builtin_amdgcn_sched_barrier(0); }
            if (half == 0) top16_of_128(sc, hi, T1); else top16_of_128(sc, hi, T2);
            __builtin_amdgcn_sched_barrier(0);
        }
        int C[16], Gc[16];
#pragma unroll
        for (int grp = 0; grp < 4; ++grp) {
#pragma unroll
            for (int q = 0; q < 16; ++q) Gc[q] = (int)0xff800000;
            { int n = 0, slot = 0;
#pragma unroll
              for (int a = 0; a < 16; ++a)
#pragma unroll
                  for (int bq = 0; bq < 16; ++bq) if ((a + 1) * (bq + 1) <= 16) { if (n / 16 == grp) { Gc[slot] = (mono(unmono(T1[a] & ~127) + unmono(T2[bq] & ~127)) & ~255) | (a * 16 + bq); ++slot; } ++n; } }
            if (grp == 3) CE_DESC(Gc, 0, 1); else sort16_desc(Gc);
            if (grp == 0) {
#pragma unroll
                for (int q = 0; q < 16; ++q) C[q] = Gc[q];
            } else merge16_desc(C, Gc);
            __builtin_amdgcn_sched_barrier(0);
        }
        float best[16]; int eidx[16]; float den = 0.f;
#pragma unroll
        for (int q = 0; q < 16; ++q) {
            const int code = C[q] & 255, ca = code >> 4, cb = code & 15; int i1 = 0, i2 = 0;
#pragma unroll
            for (int a = 0; a < 16; ++a) { i1 = (ca == a) ? (T1[a] & 127) : i1; i2 = (cb == a) ? (T2[a] & 127) : i2; }
            eidx[q] = i1 * 128 + i2;
            best[q] = __expf(unmono(C[q] & ~255) - unmono(C[0] & ~255)); den += best[q];
        }
        const float rden = 1.f / den;
        if (hi == 0) {
            int* ip = IDX + (size_t)tok * 128 + h * 16; float* gp = GATE + (size_t)tok * 128 + h * 16;
#pragma unroll
            for (int q = 0; q < 16; q += 4) { *(int4*)(ip + q) = make_int4(eidx[q], eidx[q + 1], eidx[q + 2], eidx[q + 3]); *(f32x4*)(gp + q) = (f32x4){best[q] * rden, best[q + 1] * rden, best[q + 2] * rden, best[q + 3] * rden}; }
        }
    }
}
__device__ __forceinline__ float dot2bf(unsigned w, unsigned x, float acc) { return __builtin_amdgcn_fdot2_f32_bf16(__builtin_bit_cast(bf16x2_t, w), __builtin_bit_cast(bf16x2_t, x), acc, false); }
__device__ __forceinline__ float gelu_erf(float x) { return 0.5f * x * (1.f + erff(x * 0.70710678118654752f)); }
typedef _Float16 h16x2 __attribute__((ext_vector_type(2)));
__device__ __forceinline__ float cf_pack(float c) { const _Float16 h = (_Float16)c; return __builtin_bit_cast(float, (h16x2){h, h}); }
__device__ __forceinline__ void p8_peer_gather(Frame& F) {
    int t_ = F.wave * 64 + lane_id_v();
    const int tid = t_, lane = tid & 63, wave = F.wave, sub = lane & 7, pg = lane >> 3;
    unsigned* idx_s = (unsigned*)F.lds;
    float* cf_s = (float*)(F.lds + 33280);
    float* part_s = (float*)(F.lds + 2 * 33280);
    unsigned char* xs_base = F.lds + 2 * 33280 + 4096 + wave * 6144;
    const unsigned char* X1Q = F.ws + WS_C;
    const bf16* X1B = (const bf16*)(F.ws + WS_A); const char* UQ = (const char*)(F.ws + WS_G); const char* VQ = (const char*)(F.ws + WS_G + 64 * MiB);
    const int* IDX = (const int*)(F.ws + WS_IDX); const float* GATE = (const float*)(F.ws + WS_GATE);
    float* Y = F.out + O_Y;
    __syncthreads();
    { int iv[17]; float gv[17];
#pragma unroll
      for (int i = 0; i < 17; ++i) { const int k = tid + 512 * i; if (k < 65 * 128) { const size_t m = (size_t)F.bid + 256 * (k >> 7); iv[i] = IDX[m * 128 + (k & 127)]; gv[i] = GATE[m * 128 + (k & 127)]; } }
#pragma unroll
      for (int i = 0; i < 17; ++i) { const int k = tid + 512 * i; if (k < 65 * 128) { const int j = k >> 7, p = k & 127; const int pos = j * 128 + (p & 7) * 16 + (p >> 3);
          idx_s[pos] = (unsigned)iv[i] * 2048u; cf_s[pos] = gv[i]; } } }
    __syncthreads();
    int acc[9][16];
#pragma unroll
    for (int q = 0; q < 9; ++q)
#pragma unroll
        for (int i = 0; i < 16; ++i) acc[q][i] = 0;
#ifndef NREP_U
#define NREP_U 1
#endif
#ifndef NREP_V
#define NREP_V 1
#endif
    { const int tsl = lane >> 4, pc = lane & 15;
#pragma unroll
      for (int r = 0; r < 3; ++r) { const int q = 4 * r + tsl; const int j = q < 8 ? wave + 8 * q : 64;
          __builtin_amdgcn_global_load_lds((const unsigned*)(X1Q + ((size_t)F.bid + 256 * j) * DM + 16 * pc), (LAS unsigned*)(xs_base + 1024 * r), 16, 0, 0); } }
    v4u d[16];
    { const unsigned uo0 = sub * 16;
#pragma unroll
      for (int g = 0; g < 4; ++g) { const v4u iv = *(const v4u*)(idx_s + wave * 128 + pg * 16 + 4 * g);
          d[4 * g] = *(const v4u*)(UQ + (size_t)(iv.x + uo0)); d[4 * g + 1] = *(const v4u*)(UQ + (size_t)(iv.y + uo0)); d[4 * g + 2] = *(const v4u*)(UQ + (size_t)(iv.z + uo0)); d[4 * g + 3] = *(const v4u*)(UQ + (size_t)(iv.w + uo0)); } }
    for (int s_ = 0; s_ < 16 * NREP_U; ++s_) { const int s = s_ & 15;
        if (NREP_U > 1 && s_ == 16) {
#pragma unroll
            for (int q = 0; q < 9; ++q)
#pragma unroll
                for (int i = 0; i < 16; ++i) acc[q][i] = 0;
        }
        asm volatile("s_waitcnt vmcnt(0) lgkmcnt(0)" ::: "memory");
        if (s_ + 1 < 16 * NREP_U) { const int tsl = lane >> 4, pc = lane & 15;
#pragma unroll
          for (int r = 0; r < 3; ++r) { const int q = 4 * r + tsl; const int j = q < 8 ? wave + 8 * q : 64;
              __builtin_amdgcn_global_load_lds((const unsigned*)(X1Q + ((size_t)F.bid + 256 * j) * DM + 256 * ((s + 1) & 15) + 16 * pc), (LAS unsigned*)(xs_base + ((s_ + 1) & 1) * 3072 + 1024 * r), 16, 0, 0); } }
        const unsigned char* xs_w = xs_base + (s_ & 1) * 3072;
        const unsigned uoff = s * 128 + sub * 16;
#pragma unroll
        for (int q = 0; q < 9; ++q) { const int j = q < 8 ? wave + 8 * q : 64;
            if (q < 8 ? (wave + 8 * q < 65) : ((s & 7) == wave)) {
                const bool v8 = (s & 7) == wave, nsame = (q < 7) || (q == 7 && v8), nlast = !nsame && !(s_ + 1 < 16 * NREP_U);
                const int nj = nsame ? (q + 1 < 8 ? wave + 8 * (q + 1) : 64) : (nlast ? j : wave);
                const unsigned noff = (nsame || nlast) ? uoff : ((s + 1) & 15) * 128 + sub * 16;
                const v4u xr0 = *(const v4u*)(xs_w + q * 256 + 32 * sub), xr1 = *(const v4u*)(xs_w + q * 256 + 32 * sub + 16);
                const int xg[8] = {(int)xr0.x, (int)xr0.y, (int)xr0.z, (int)xr0.w, (int)xr1.x, (int)xr1.y, (int)xr1.z, (int)xr1.w};
#pragma unroll
                for (int i = 0; i < 16; ++i) { int a = acc[q][i];
#pragma unroll
                    for (int g = 0; g < 4; ++g) { const unsigned w = d[i][g];
                        a = __builtin_amdgcn_sdot4((int)((w << 4) & 0xf0f0f0f0u), xg[2 * g], a, false);
                        a = __builtin_amdgcn_sdot4((int)(w & 0xf0f0f0f0u), xg[2 * g + 1], a, false); }
                    acc[q][i] = a;
                    d[i] = *(const v4u*)(UQ + (size_t)(idx_s[nj * 128 + pg * 16 + i] + noff)); }
            }
        }
    }
#pragma unroll
    for (int q = 0; q < 9; ++q) { const int j = q < 8 ? wave + 8 * q : 64;
#pragma unroll
        for (int i = 0; i < 16; ++i) { float v = (float)acc[q][i]; v += xor1(v); v += xor2(v); v += xor4s(v);
            if (sub == 0) { if (q < 8) { const int pos = j * 128 + pg * 16 + i; cf_s[pos] = cf_pack(cf_s[pos] * gelu_erf(v * (1.f / 73728.f)) * 0.125f); } else part_s[wave * 128 + pg * 16 + i] = v; } } }
    __syncthreads();
    if (tid < 128) { float v = 0.f;
#pragma unroll
        for (int w = 0; w < 8; ++w) v += part_s[w * 128 + tid];
        cf_s[64 * 128 + tid] = cf_pack(cf_s[64 * 128 + tid] * gelu_erf(v * (1.f / 73728.f)) * 0.125f); }
    __syncthreads();
    { const unsigned vo0 = sub * 16;
#pragma unroll
      for (int g = 0; g < 4; ++g) { const v4u iv = *(const v4u*)(idx_s + wave * 128 + pg * 16 + 4 * g);
          d[4 * g] = *(const v4u*)(VQ + (size_t)(iv.x + vo0)); d[4 * g + 1] = *(const v4u*)(VQ + (size_t)(iv.y + vo0)); d[4 * g + 2] = *(const v4u*)(VQ + (size_t)(iv.z + vo0)); d[4 * g + 3] = *(const v4u*)(VQ + (size_t)(iv.w + vo0)); } }
    for (int s_ = 0; s_ < 16 * NREP_V; ++s_) { const int s = s_ & 15;
        const unsigned voff = s * 128 + sub * 16;
        const int jend = (s & 7) == wave ? 72 : 64;
#pragma unroll 1
        for (int jj = wave; jj < jend; jj += 8) { const int j = jj < 64 ? jj : 64;
            const bool nsame = jj + 8 < jend, nlast = !nsame && !(s_ + 1 < 16 * NREP_V);
            const int nj = nsame ? (jj + 8 < 64 ? jj + 8 : 64) : (nlast ? j : wave);
            const unsigned noff = (nsame || nlast) ? voff : ((s + 1) & 15) * 128 + sub * 16;
            bf16* yp = (bf16*)X1B + ((size_t)F.bid + 256 * j) * DM + 256 * s + 32 * sub + 16 * (pg >> 2) + 4 * (pg & 3);
            const bool wr = s_ >= 16 * (NREP_V - 1);
            v2u xw4 = {0u, 0u};
            if (wr) xw4 = *(const v2u*)yp;
            const f32x4 c0 = *(const f32x4*)(cf_s + j * 128 + pg * 16), c1 = *(const f32x4*)(cf_s + j * 128 + pg * 16 + 4), c2 = *(const f32x4*)(cf_s + j * 128 + pg * 16 + 8), c3 = *(const f32x4*)(cf_s + j * 128 + pg * 16 + 12);
            const float cc[16] = {c0[0], c0[1], c0[2], c0[3], c1[0], c1[1], c1[2], c1[3], c2[0], c2[1], c2[2], c2[3], c3[0], c3[1], c3[2], c3[3]};
            h16x2 ya[16];
#pragma unroll
            for (int e = 0; e < 16; ++e) ya[e] = (h16x2){(_Float16)0.f, (_Float16)0.f};
#pragma unroll
            for (int i = 0; i < 16; ++i) { const h16x2 cf2 = __builtin_bit_cast(h16x2, cc[i]);
#pragma unroll
                for (int w = 0; w < 4; ++w) { ya[4 * w] += cf2 * __builtin_amdgcn_cvt_scalef32_pk_f16_fp4(d[i][w], 1.0f, 0); ya[4 * w + 1] += cf2 * __builtin_amdgcn_cvt_scalef32_pk_f16_fp4(d[i][w], 1.0f, 1);
                    ya[4 * w + 2] += cf2 * __builtin_amdgcn_cvt_scalef32_pk_f16_fp4(d[i][w], 1.0f, 2); ya[4 * w + 3] += cf2 * __builtin_amdgcn_cvt_scalef32_pk_f16_fp4(d[i][w], 1.0f, 3); }
                d[i] = *(const v4u*)(VQ + (size_t)(idx_s[nj * 128 + pg * 16 + i] + noff)); }
            h16x2 tt[8];
#pragma unroll
            for (int e = 0; e < 8; ++e) {
                const auto rr = __builtin_amdgcn_permlane32_swap(__builtin_bit_cast(unsigned, ya[e]), __builtin_bit_cast(unsigned, ya[e + 8]), false, false);
                h16x2 t = __builtin_bit_cast(h16x2, (unsigned)rr[0]) + __builtin_bit_cast(h16x2, (unsigned)rr[1]);
                t += __builtin_bit_cast(h16x2, xor16(__builtin_bit_cast(float, t)));
                t += __builtin_bit_cast(h16x2, xor8(__builtin_bit_cast(float, t)));
                tt[e] = t; }
            const int kq = pg & 3;
            const h16x2 ta = kq == 0 ? tt[0] : kq == 1 ? tt[2] : kq == 2 ? tt[4] : tt[6], tb = kq == 0 ? tt[1] : kq == 1 ? tt[3] : kq == 2 ? tt[5] : tt[7];
            if (wr) { v2u o2;
                o2.x = pk2(fmaf(ALPHA_RES, __uint_as_float(xw4.x << 16), (float)ta.x), fmaf(ALPHA_RES, __uint_as_float(xw4.x & 0xffff0000u), (float)ta.y));
                o2.y = pk2(fmaf(ALPHA_RES, __uint_as_float(xw4.y << 16), (float)tb.x), fmaf(ALPHA_RES, __uint_as_float(xw4.y & 0xffff0000u), (float)tb.y));
                *(v2u*)yp = o2; }
        }
    }
    VM_WAIT(); __syncthreads(); __builtin_amdgcn_fence(__ATOMIC_ACQUIRE, "agent"); VM_WAIT();
    v4u wn[8];
#pragma unroll
    for (int k = 0; k < 8; ++k) wn[k] = *(const v4u*)(X1B + ((size_t)F.bid + 256 * wave) * DM + 8 * (lane + 64 * k));
    for (int q = 0; q < 9; ++q) { const int j = wave + 8 * q; if (j >= 65) break;
        const size_t m = (size_t)F.bid + 256 * j; float* yr = Y + m * DM; float v[8][8]; float s = 0.f;
#pragma unroll
        for (int k = 0; k < 8; ++k) { const unsigned ww[4] = {wn[k].x, wn[k].y, wn[k].z, wn[k].w};
#pragma unroll
            for (int e = 0; e < 4; ++e) { v[k][2 * e] = __uint_as_float(ww[e] << 16); v[k][2 * e + 1] = __uint_as_float(ww[e] & 0xffff0000u); s += v[k][2 * e] + v[k][2 * e + 1]; } }
        if (j + 8 < 65) {
#pragma unroll
            for (int k = 0; k < 8; ++k) wn[k] = *(const v4u*)(X1B + (m + 2048) * DM + 8 * (lane + 64 * k)); }
        const float mean = wave_sum(s) * (1.f / DM); float s2 = 0.f;
#pragma unroll
        for (int k = 0; k < 8; ++k)
#pragma unroll
            for (int e = 0; e < 8; ++e) { v[k][e] -= mean; s2 += v[k][e] * v[k][e]; }
        const float rstd = rsqrtf(wave_sum(s2) * (1.f / DM) + LN_EPS);
#pragma unroll
        for (int k = 0; k < 8; ++k) { const int c = 8 * (lane + 64 * k);
            const f32x4 g0 = *(const f32x4*)(F.ln2g + c), g1 = *(const f32x4*)(F.ln2g + c + 4), b0 = *(const f32x4*)(F.ln2b + c), b1 = *(const f32x4*)(F.ln2b + c + 4);
            *(f32x4*)(yr + c) = (f32x4){v[k][0] * rstd * g0[0] + b0[0], v[k][1] * rstd * g0[1] + b0[1], v[k][2] * rstd * g0[2] + b0[2], v[k][3] * rstd * g0[3] + b0[3]};
            *(f32x4*)(yr + c + 4) = (f32x4){v[k][4] * rstd * g1[0] + b1[0], v[k][5] * rstd * g1[1] + b1[1], v[k][6] * rstd * g1[2] + b1[2], v[k][7] * rstd * g1[3] + b1[3]}; }
    }
}
#ifndef MK_N_LAUNCHES
#define MK_N_LAUNCHES 1
#endif
constexpr int NPH = 10;
struct Args { const float* in[24]; float* out; unsigned char* ws; int ph_lo, ph_hi; };
__global__ void __launch_bounds__(NWAVES * 64, 2) fwd_kernel(Args args) {
    extern __shared__ __attribute__((aligned(16))) unsigned char lds[];
    Frame F;
    F.lds = lds; F.wave = __builtin_amdgcn_readfirstlane((int)threadIdx.x >> 6); F.G = gridDim.x; F.bid = blockIdx.x;
    F.ws = args.ws; F.out = args.out; F.ctl = (gu32*)(args.ws + WS_CTL);
    F.x_p = args.in[0]; F.x_s = args.in[1]; F.cache_k = args.in[2]; F.cache_v = args.in[3]; F.state = args.in[4]; F.w_in = args.in[5]; F.w_gate2 = args.in[6]; F.b_gate = args.in[7];
    F.lq1 = args.in[8]; F.lk1 = args.in[9]; F.lq2 = args.in[10]; F.lk2 = args.in[11]; F.dng = args.in[12]; F.gng = args.in[13]; F.w_out = args.in[14];
    F.ln1g = args.in[15]; F.ln1b = args.in[16]; F.ln2g = args.in[17]; F.ln2b = args.in[18]; F.peer_wq = args.in[19]; F.keys1 = args.in[20]; F.keys2 = args.in[21]; F.peer_u = args.in[22]; F.peer_v = args.in[23];
    for (int u = ((int)threadIdx.x); u < (LDS_BYTES - MISC_OFF) / 4; u += NWAVES * 64) ((unsigned*)(lds + MISC_OFF))[u] = 0u;
    __syncthreads();
    const int lo = args.ph_lo, hi = args.ph_hi;
    XcdBarrier bar; bar.bar = (unsigned*)(F.ctl + CW_BAR); bar.x = 0; bar.st = nullptr;
    if (hi - lo > 1) bar = xcd_barrier_post((unsigned*)(F.ctl + CW_BAR), (volatile LAS unsigned*)(lds + MISC_OFF));
#ifndef PH_MASK
#define PH_MASK 0x3ff
#endif
#define IN(k) (((PH_MASK >> (k)) & 1) && lo <= (k) && (k) < hi)
#define SEAM(k) do { if (IN(k) && IN((k) + 1)) xcd_barrier(bar); } while (0)
    PG8_LAS unsigned char* glds = (PG8_LAS unsigned char*)lds;
#ifndef REPMASK
#define REPMASK 0
#endif
#define REP(k) ((REPMASK >> (k)) & 1)
    if (IN(0)) { p0_prologue(F); if (REP(0)) p0_prologue(F); SEAM(0); }
    if (IN(1)) {
        pg8::Gemm g{(const pg8::bf16_t*)(F.ws + WS_A), (const pg8::bf16_t*)(F.ws + WS_B), MTOK, NPROJ_PAD, DM}; pg8::StaticOrder S; S.init(MTOK, NPROJ_PAD, F.G, F.bid);
        pg8::EpiProj E;
        E.QKV = (pg8::bf16_t*)(F.ws + WS_C); E.GB = (pg8::bf16_t*)(F.ws + WS_D);
        E.GZ = (float*)(F.ws + WS_GZ); E.outKp = F.out + O_KP; E.outKs = F.out + O_KS; E.outVp = F.out + O_VP; E.outVs = F.out + O_VS; E.rope = (const float*)(F.ws + WS_ROPE); E.pn0 = 0;
#ifdef GAPTEST
        { pg8::StaticOrder Sa = S; Sa.iend = 6; pg8::gemm_phase<pg8::EpiProj, pg8::StaticOrder, true, true>(glds, g, Sa, E, F.wave * 64 + lane_id_v());
          const unsigned long long t0 = __builtin_amdgcn_s_memrealtime(); while (__builtin_amdgcn_s_memrealtime() - t0 < (unsigned long long)GAPTEST * 100ull) __builtin_amdgcn_s_sleep(32);
          pg8::StaticOrder Sb = S; Sb.ibeg = 6; pg8::gemm_phase<pg8::EpiProj, pg8::StaticOrder, true, true>(glds, g, Sb, E, F.wave * 64 + lane_id_v()); }
#else
        pg8::gemm_phase<pg8::EpiProj, pg8::StaticOrder, true, true>(glds, g, S, E, F.wave * 64 + lane_id_v());
#endif
        if (REP(1)) pg8::gemm_phase<pg8::EpiProj, pg8::StaticOrder, true, true>(glds, g, S, E, F.wave * 64 + lane_id_v());
#ifdef REPSUB_PN0
        { pg8::Gemm g2{(const pg8::bf16_t*)(F.ws + WS_A), (const pg8::bf16_t*)(F.ws + WS_B) + (size_t)REPSUB_PN0 * 256 * DM, TP, REPSUB_NT * 256, DM}; pg8::StaticOrder S2; S2.init(TP, REPSUB_NT * 256, F.G, F.bid);
          pg8::EpiProj E2 = E; E2.pn0 = REPSUB_PN0;
          pg8::gemm_phase<pg8::EpiProj, pg8::StaticOrder, true, true>(glds, g2, S2, E2, F.wave * 64 + lane_id_v()); }
#endif
        if ((long)12 * F.G + F.bid >= (long)(MTOK / 256) * (NPROJ_PAD / 256)) cvt_cache_drain(F, 2);
        SEAM(1);
    }
    if (IN(2)) { cvt_cache_drain(F, 144); p2_gla_prep(F); if (REP(2)) p2_gla_prep(F); SEAM(2); }
    if (IN(3)) { p3_attn_scan(F); SEAM(3); }
    if (IN(5)) {
        pg8::Gemm g{(const pg8::bf16_t*)(F.ws + WS_F), (const pg8::bf16_t*)(F.ws + WS_WOUT), MTOK, DM, DM}; pg8::StaticOrder S; S.init(MTOK, DM, F.G, F.bid);
        pg8::EpiMix E{F.x_p, F.x_s, (pg8::bf16_t*)(F.ws + WS_A), ALPHA_RES};
        pg8::gemm_phase<pg8::EpiMix, pg8::StaticOrder, true, true>(glds, g, S, E, F.wave * 64 + lane_id_v());
        if (REP(5)) pg8::gemm_phase<pg8::EpiMix, pg8::StaticOrder, true, true>(glds, g, S, E, F.wave * 64 + lane_id_v());
        if ((long)4 * F.G + F.bid >= (long)(MTOK / 256) * (DM / 256)) cvt_tables_drain(F, 3);
        SEAM(5);
    }
    if (IN(6)) { if (REP(6)) p5_ln1(F, true); p5_ln1(F, false); SEAM(6); }
    if (IN(7)) {
        pg8::Gemm g{(const pg8::bf16_t*)(F.ws + WS_A), (const pg8::bf16_t*)(F.ws + WS_WQ), MTOK, 2048, DM}; pg8::StaticOrder S; S.init(MTOK, 2048, F.G, F.bid);
        pg8::EpiBf16<0> E{(pg8::bf16_t*)(F.ws + WS_B), 2048, nullptr, 0, 0, 1.f};
        pg8::gemm_phase<pg8::EpiBf16<0>, pg8::StaticOrder, true, true>(glds, g, S, E, F.wave * 64 + lane_id_v());
        if (REP(7)) pg8::gemm_phase<pg8::EpiBf16<0>, pg8::StaticOrder, true, true>(glds, g, S, E, F.wave * 64 + lane_id_v());
        if ((long)2 * F.G + F.bid >= (long)(MTOK / 256) * (2048 / 256)) cvt_tables_drain(F, 3);
        SEAM(7);
    }
    if (IN(8)) { p7_peer_select(F); if (REP(8)) p7_peer_select(F); cvt_tables_drain(F, 512); SEAM(8); }
    if (IN(9)) { p8_peer_gather(F); }
#undef IN
#undef SEAM
}

extern "C" void kernel_launch(void* const* d_in, const int* in_sizes, int n_in, void* d_out, int out_size, void* d_ws, size_t ws_size, hipStream_t stream) {
    static int grid = 0;
    if (grid == 0) {
        if (n_in != 24 || ws_size < WS_END) { fprintf(stderr, "kernel_launch: need 24 inputs and >= %zu bytes of workspace; got %d, %zu\n", (size_t)WS_END, n_in, ws_size); grid = -1; return; }
        int dev = 0, cus = 0, per_cu = 0;
        if (hipGetDevice(&dev) != hipSuccess || hipDeviceGetAttribute(&cus, hipDeviceAttributeMultiprocessorCount, dev) != hipSuccess) { grid = -1; return; }
        if (hipFuncSetAttribute((const void*)fwd_kernel, hipFuncAttributeMaxDynamicSharedMemorySize, LDS_BYTES) != hipSuccess) { fprintf(stderr, "kernel_launch: hipFuncSetAttribute failed\n"); grid = -1; return; }
        if (hipOccupancyMaxActiveBlocksPerMultiprocessor(&per_cu, (const void*)fwd_kernel, NWAVES * 64, LDS_BYTES) != hipSuccess || per_cu < 1) { fprintf(stderr, "kernel_launch: occupancy query says %d\n", per_cu); }
        (void)hipGetLastError();
        if (cus < 256) { fprintf(stderr, "kernel_launch: built for a 256-CU device (MI355X); this one reports %d CUs\n", cus); grid = -1; return; }
        grid = 256;
    }
    if (grid < 0) return;
    (void)hipMemsetAsync((char*)d_ws + WS_CTL, 0, CTL_ZERO_BYTES, stream);
    Args a{};
    for (int i = 0; i < 24; ++i) a.in[i] = (const float*)d_in[i];
    a.out = (float*)d_out; a.ws = (unsigned char*)d_ws;
#if MK_N_LAUNCHES == 1
    a.ph_lo = 0; a.ph_hi = NPH;
    hipLaunchKernelGGL(fwd_kernel, dim3(grid), dim3(NWAVES * 64), LDS_BYTES, stream, a);
#else
    for (int p = 0; p < NPH; ++p) { a.ph_lo = p; a.ph_hi = p + 1; hipLaunchKernelGGL(fwd_kernel, dim3(grid), dim3(NWAVES * 64), LDS_BYTES, stream, a); }
#endif
    const hipError_t le = hipPeekAtLastError();
    if (le != hipSuccess) fprintf(stderr, "kernel_launch: launch failed: %s\n", hipGetErrorName(le));
}
```
